# Optimizing an MI355X kernel written in HIP

```python
import jax, jax.numpy as jnp
from jax import lax
import numpy as np

D_MODEL = 4096
BATCH = 32
SEQ = 256
DEPTH = 1
DEC_BATCH = 8
DEC_SEQ = 2048
PAST_LEN = 512

GRID_W = 64
N_HEADS = 32
N_KV_HEADS = 8
HEAD_DIM = D_MODEL // N_HEADS
Q_PER_KV = N_HEADS // N_KV_HEADS
WINDOW = 128
BLOCK = 128
CONV_DIM = D_MODEL // 2
CONV_K = 3
D_FF = 256 * ((8 * D_MODEL // 3 + 255) // 256)
ROPE_THETA = 10000.0
EPS = 1e-6
N_MOD = 6
Q_W = N_HEADS * HEAD_DIM
KV_W = N_KV_HEADS * HEAD_DIM
IN_W = Q_W + 2 * KV_W + 3 * CONV_DIM + 2 * D_MODEL
NEG = -1e30

kernel_name = 'hybrid_dit_swa_shortconv_step'


def _rmsnorm(x, g):
    xf = x.astype(jnp.float32)
    y = xf * lax.rsqrt(jnp.mean(xf * xf, axis=-1, keepdims=True) + EPS)
    return (y * g.astype(jnp.float32)).astype(x.dtype)


def _modulation(cond, w_mod, b_mod):
    m = jax.nn.silu(cond) @ w_mod + b_mod
    return m.reshape(cond.shape[:-1] + (N_MOD, D_MODEL))


def _dwconv3(x, w):
    L = x.shape[1]
    xp = jnp.pad(x, ((0, 0), (1, 1), (0, 0)))
    return xp[:, :L] * w[0] + xp[:, 1:L + 1] * w[1] + xp[:, 2:] * w[2]


def _axial_rope_tables(L):
    rows = L // GRID_W
    row = jnp.repeat(jnp.arange(rows), GRID_W).astype(jnp.float32)
    col = jnp.tile(jnp.arange(GRID_W), rows).astype(jnp.float32)
    n_freq = HEAD_DIM // 4
    inv = ROPE_THETA ** (-jnp.arange(n_freq, dtype=jnp.float32) / n_freq)
    ang = jnp.concatenate([row[:, None] * inv, col[:, None] * inv], axis=-1)
    return jnp.cos(ang), jnp.sin(ang)


def _apply_axial_rope(x, cos, sin):
    B, L, H, _ = x.shape
    nf = HEAD_DIM // 4
    xf = x.astype(jnp.float32).reshape(B, L, H, 2, 2, nf)
    x1, x2 = xf[..., 0, :], xf[..., 1, :]
    c = cos.reshape(L, 1, 2, nf)
    s = sin.reshape(L, 1, 2, nf)
    out = jnp.stack([x1 * c - x2 * s, x1 * s + x2 * c], axis=-2)
    return out.reshape(B, L, H, HEAD_DIM).astype(x.dtype)


def _sink_attend(q_blk, k, v, sink, mask=None):
    B, Q = q_blk.shape[:2]
    qg = q_blk.reshape(B, Q, N_KV_HEADS, Q_PER_KV, HEAD_DIM)
    s = jnp.einsum('bqkgd,btkd->bkgqt', qg, k, preferred_element_type=jnp.float32) * (HEAD_DIM ** -0.5)
    if mask is not None:
        s = jnp.where(mask, s, NEG)
    sk = sink.astype(jnp.float32).reshape(1, N_KV_HEADS, Q_PER_KV, 1, 1)
    m = jnp.maximum(jnp.max(s, axis=-1, keepdims=True), sk)
    p = jnp.exp(s - m)
    p = (p / (jnp.sum(p, axis=-1, keepdims=True) + jnp.exp(sk - m))).astype(v.dtype)
    o = jnp.einsum('bkgqt,btkd->bqkgd', p, v)
    return o.reshape(B, Q, Q_W)


def _context_attention(q, k, v, sink):
    B, S = q.shape[:2]
    nb = S // BLOCK
    qb = q.reshape(B, nb, BLOCK, N_HEADS, HEAD_DIM).transpose(1, 0, 2, 3, 4)
    out = lax.map(lambda qi: _sink_attend(qi, k, v, sink), qb)
    return out.transpose(1, 0, 2, 3).reshape(B, S, Q_W)


def _latent_attention(q, k, v, k_ctx, v_ctx, sink):
    B, L = q.shape[:2]
    P = k_ctx.shape[1]
    nb = L // BLOCK
    pad = ((0, 0), (BLOCK, BLOCK), (0, 0), (0, 0))
    kp = jnp.pad(k, pad)
    vp = jnp.pad(v, pad)
    ctx_mask = jnp.ones((BLOCK, P), dtype=bool)

    def block(b):
        start = b * BLOCK
        qi = lax.dynamic_slice_in_dim(q, start, BLOCK, axis=1)
        kb = lax.dynamic_slice_in_dim(kp, start, 3 * BLOCK, axis=1)
        vb = lax.dynamic_slice_in_dim(vp, start, 3 * BLOCK, axis=1)
        qpos = start + jnp.arange(BLOCK)
        kpos = start - BLOCK + jnp.arange(3 * BLOCK)
        band = ((kpos[None, :] >= 0) & (kpos[None, :] < L)
                & (jnp.abs(qpos[:, None] - kpos[None, :]) <= WINDOW))
        keys = jnp.concatenate([kb, k_ctx], axis=1)
        vals = jnp.concatenate([vb, v_ctx], axis=1)
        mask = jnp.concatenate([band, ctx_mask], axis=1)
        return _sink_attend(qi, keys, vals, sink, mask)

    out = lax.map(block, jnp.arange(nb))
    return out.transpose(1, 0, 2, 3).reshape(B, L, Q_W)


def _layer(x, mod, attend, w_in, w_sconv, w_attn_o, w_conv_o, w_mix_out,
           g_pre_mix, g_post_mix, g_pre_ffn, w_ffn_up, w_ffn_conv, w_ffn_down, g_post_ffn):
    B, L = x.shape[:2]
    shift_a, scale_a, gate_a, shift_f, scale_f, gate_f = [mod[:, i][:, None, :] for i in range(N_MOD)]

    h = _rmsnorm(x, g_pre_mix) * (1 + scale_a) + shift_a
    proj = h @ w_in
    i0 = Q_W
    i1 = i0 + KV_W
    i2 = i1 + KV_W
    i3 = i2 + CONV_DIM
    i4 = i3 + CONV_DIM
    i5 = i4 + CONV_DIM
    i6 = i5 + D_MODEL
    q = proj[..., :i0].reshape(B, L, N_HEADS, HEAD_DIM)
    k = proj[..., i0:i1].reshape(B, L, N_KV_HEADS, HEAD_DIM)
    v = proj[..., i1:i2].reshape(B, L, N_KV_HEADS, HEAD_DIM)
    cb, cc, ch = proj[..., i2:i3], proj[..., i3:i4], proj[..., i4:i5]
    g_att, g_conv = proj[..., i5:i6], proj[..., i6:]

    a = attend(q, k, v)
    sc = cb * _dwconv3(cc * ch, w_sconv)
    merged = jax.nn.sigmoid(g_att) * (a @ w_attn_o) + jax.nn.sigmoid(g_conv) * (sc @ w_conv_o)
    x = x + gate_a * _rmsnorm(merged @ w_mix_out, g_post_mix)

    h = _rmsnorm(x, g_pre_ffn) * (1 + scale_f) + shift_f
    u = h @ w_ffn_up
    gt, val = u[..., :D_FF], u[..., D_FF:]
    f = (jax.nn.silu(_dwconv3(gt, w_ffn_conv)) * val) @ w_ffn_down
    x = x + gate_f * _rmsnorm(f, g_post_ffn)
    return x, k, v


def setup_inputs(seed: int = 0) -> dict:
    key = jax.random.key(seed)
    ks = jax.random.split(key, 24)
    f32 = jnp.float32

    def nrm(k, shape, s):
        return jax.random.normal(k, shape, f32) * s

    def gain(k):
        return 1.0 + 0.05 * jax.random.normal(k, (DEPTH, D_MODEL), f32)

    return {
        'x_prompt': nrm(ks[0], (BATCH, SEQ, D_MODEL), 1.0),
        'x_sample': nrm(ks[1], (DEC_BATCH, DEC_SEQ, D_MODEL), 1.0),
        'cache_k': nrm(ks[2], (DEC_BATCH, DEPTH, PAST_LEN, N_KV_HEADS, HEAD_DIM), 1.0),
        'cache_v': nrm(ks[3], (DEC_BATCH, DEPTH, PAST_LEN, N_KV_HEADS, HEAD_DIM), 1.0),
        'c': nrm(ks[4], (DEC_BATCH, D_MODEL), 1.0),
        'c_ctx': nrm(ks[5], (D_MODEL,), 1.0),
        'w_mod': nrm(ks[6], (DEPTH, D_MODEL, N_MOD * D_MODEL), 0.5 * D_MODEL ** -0.5),
        'b_mod': nrm(ks[7], (DEPTH, N_MOD * D_MODEL), 0.01),
        'g_pre_mix': gain(ks[8]),
        'w_in': nrm(ks[9], (DEPTH, D_MODEL, IN_W), D_MODEL ** -0.5),
        'w_sconv': nrm(ks[10], (DEPTH, CONV_K, CONV_DIM), CONV_K ** -0.5),
        'attn_sink': nrm(ks[11], (DEPTH, N_HEADS), 1.0),
        'w_attn_o': nrm(ks[12], (DEPTH, Q_W, D_MODEL), Q_W ** -0.5),
        'w_conv_o': nrm(ks[13], (DEPTH, CONV_DIM, D_MODEL), CONV_DIM ** -0.5),
        'w_mix_out': nrm(ks[14], (DEPTH, D_MODEL, D_MODEL), D_MODEL ** -0.5),
        'g_post_mix': gain(ks[15]),
        'g_pre_ffn': gain(ks[16]),
        'w_ffn_up': nrm(ks[17], (DEPTH, D_MODEL, 2 * D_FF), D_MODEL ** -0.5),
        'w_ffn_conv': nrm(ks[18], (DEPTH, CONV_K, D_FF), CONV_K ** -0.5),
        'w_ffn_down': nrm(ks[19], (DEPTH, D_FF, D_MODEL), D_FF ** -0.5),
        'g_post_ffn': gain(ks[20]),
    }


def reference(x_prompt, x_sample, cache_k, cache_v, c, c_ctx, w_mod, b_mod, g_pre_mix, w_in,
              w_sconv, attn_sink, w_attn_o, w_conv_o, w_mix_out, g_post_mix, g_pre_ffn,
              w_ffn_up, w_ffn_conv, w_ffn_down, g_post_ffn):
    cos, sin = _axial_rope_tables(x_sample.shape[1])
    xp, xs = x_prompt, x_sample
    new_k, new_v = [], []
    for l in range(DEPTH):
        lw = (w_in[l], w_sconv[l], w_attn_o[l], w_conv_o[l], w_mix_out[l], g_pre_mix[l],
              g_post_mix[l], g_pre_ffn[l], w_ffn_up[l], w_ffn_conv[l], w_ffn_down[l], g_post_ffn[l])
        sink = attn_sink[l]
        mod_ctx = _modulation(c_ctx[None, :], w_mod[l], b_mod[l])
        mod_lat = _modulation(c, w_mod[l], b_mod[l])

        def ctx_attend(q, k, v, sink=sink):
            return _context_attention(q, k, v, sink)

        def lat_attend(q, k, v, sink=sink, k_ctx=cache_k[:, l], v_ctx=cache_v[:, l]):
            return _latent_attention(_apply_axial_rope(q, cos, sin), _apply_axial_rope(k, cos, sin),
                                     v, k_ctx, v_ctx, sink)

        xp, k_l, v_l = _layer(xp, mod_ctx, ctx_attend, *lw)
        xs, _, _ = _layer(xs, mod_lat, lat_attend, *lw)
        new_k.append(k_l)
        new_v.append(v_l)
    k_state = jnp.stack(new_k, axis=1)
    v_state = jnp.stack(new_v, axis=1)
    return (xp, xs, k_state, v_state)
```

```cpp
#include <hip/hip_runtime.h>
#include <cstdio>
#include <cstdint>

constexpr int DM = 4096, NCTX = 8192, NLAT = 16384, MTOT = 24576;
constexpr int INW = 20480, DFF = 11008, UPW = 22016, KVW = 1024, CONVD = 2048, PAST = 512;
constexpr int C_Q = 0, C_K = 4096, C_V = 5120, C_CB = 6144, C_CC = 8192, C_CH = 10240, C_GA = 12288, C_GC = 16384;
constexpr float EPS = 1e-6f;

namespace pg8 {
#define PG8_LAS __attribute__((address_space(3)))
typedef unsigned short bf16_t;
typedef short bf16x8 __attribute__((ext_vector_type(8)));
typedef float f32x4 __attribute__((ext_vector_type(4)));
typedef unsigned u32x4 __attribute__((ext_vector_type(4)));
typedef int i32x4 __attribute__((ext_vector_type(4)));
constexpr int BM = 256, BK = 64, HALF = 128, HTB = HALF * BK * 2  , STAGE_BYTES = 8 * HTB, NXCD = 8, WGM = 8;

__host__ __device__ __forceinline__ int lds_byte(int r, int c) { const int st = (r >> 4) * 2 + (c >> 5), rr = r & 15, cc = c & 31, ob = rr * 64 + cc * 2; return st * 1024 + (ob ^ (((ob >> 9) & 1) << 5)); }
__host__ __device__ __forceinline__ void stage_rc(int b, int& R, int& C) { const int st = b / 1024, sb = b % 1024, swz = sb ^ (((sb >> 9) & 1) << 5); R = (st >> 1) * 16 + swz / 64; C = (st & 1) * 32 + (swz % 64) / 2; }
__host__ __device__ __forceinline__ int perm32(int rho) { const int n = rho >> 4, i = rho & 15; return 8 * (i >> 2) + 4 * n + (i & 3); }

struct Unit { int pm, pn, pnb; };
struct Gemm { const bf16_t* A; const bf16_t* Bt; int M, N, K, lda, kj_t, kj_bytes; };

struct StaticOrder {
    int nM, nN, nwg, G, c;
    __host__ __device__ void init(int M, int N, int G_, int c_) { nM = M / BM; nN = N / BM; nwg = nM * nN; G = G_; c = c_; }
    __host__ __device__ bool next(int i, Unit& u) const {
        const long L = (long)i * G + c; if (L >= nwg) return false;
        int wgid = (int)L; { const int q = nwg / NXCD, r = nwg % NXCD, xcd = wgid % NXCD, off = wgid / NXCD; wgid = (xcd < r ? xcd * (q + 1) : r * (q + 1) + (xcd - r) * q) + off; }
        const int nig = WGM * nN, gid = wgid / nig, fm = gid * WGM, gsz = (nM - fm) < WGM ? (nM - fm) : WGM;
        u.pm = fm + ((wgid % nig) % gsz); u.pn = (wgid % nig) / gsz; u.pnb = u.pn; return true;
    }
    __device__ __forceinline__ void a_ready(const Unit&) const {}
    __device__ __forceinline__ void done(const Unit&) const {}
};
struct GroupOrder {
    int nM, nN, nwg, G, c, split = 1 << 30, off0 = 0, off1 = 0;
    __host__ __device__ void init(int M, int N, int G_, int c_) { nM = M / BM; nN = N / BM; nwg = nM * nN; G = G_; c = c_; }
    __host__ __device__ bool next(int i, Unit& u) const {
        const long L = (long)i * G + c; if (L >= nwg) return false;
        const int w = (int)L, nig = WGM * nN, gid = w / nig, fm = gid * WGM, gsz = (nM - fm) < WGM ? (nM - fm) : WGM;
        u.pm = fm + ((w % nig) % gsz); u.pnb = (w % nig) / gsz; u.pn = u.pnb + (u.pnb < split ? off0 : off1); return true;
    }
    __device__ __forceinline__ void a_ready(const Unit&) const {}
    __device__ __forceinline__ void done(const Unit&) const {}
};

__device__ __forceinline__ unsigned cvt_pk_bf16(float lo, float hi) { unsigned r; asm volatile("v_cvt_pk_bf16_f32 %0, %1, %2" : "=v"(r) : "v"(lo), "v"(hi)); return r; }
__device__ __forceinline__ float bf_lo(unsigned w) { return __uint_as_float(w << 16); }
__device__ __forceinline__ float bf_hi(unsigned w) { return __uint_as_float(w & 0xffff0000u); }
__device__ __forceinline__ u32x4 pack8(const f32x4 v0, const f32x4 v1) { u32x4 w; w.x = cvt_pk_bf16(v0[0], v0[1]); w.y = cvt_pk_bf16(v0[2], v0[3]); w.z = cvt_pk_bf16(v1[0], v1[1]); w.w = cvt_pk_bf16(v1[2], v1[3]); return w; }

struct EpiStore {
    typedef f32x4 acc_t;
    static constexpr bool PERM = true, HAS_MID = false;
    bf16_t* O; int ldc;
    __device__ __forceinline__ void mid(f32x4 (&)[2][2][4][2], const Unit&, int, int, int, int) const {}
    __device__ __forceinline__ void operator()(const f32x4 (&acc)[2][2][4][2], const Unit& u, int wr, int wc, int fr_, int fq_) const {
        int fr = fr_, fq = fq_; asm volatile("" : "+v"(fr), "+v"(fq));
        const int row0 = u.pm * BM + wr * 64 + fr, col0 = u.pn * BM + wc * 32 + 8 * fq;
#pragma unroll
        for (int ai = 0; ai < 2; ++ai)
#pragma unroll
            for (int m = 0; m < 4; ++m) { bf16_t* rowp = O + (size_t)(row0 + ai * HALF + m * 16) * ldc + col0;
#pragma unroll
                for (int bj = 0; bj < 2; ++bj) *(u32x4*)(rowp + bj * HALF) = pack8(acc[ai][bj][m][0], acc[ai][bj][m][1]); }
    }
};

struct EpiIn {
    typedef f32x4 acc_t;
    static constexpr bool PERM = true, HAS_MID = false;
    bf16_t* P; float* newk; float* newv; const float* rcos; const float* rsin;
    __device__ __forceinline__ void mid(f32x4 (&)[2][2][4][2], const Unit&, int, int, int, int) const {}
    __device__ __forceinline__ void operator()(const f32x4 (&acc)[2][2][4][2], const Unit& u, int wr, int wc, int fr_, int fq_) const {
        int fr = fr_, fq = fq_; asm volatile("" : "+v"(fr), "+v"(fq));
        const int row0 = u.pm * BM + wr * 64 + fr, col0 = u.pn * BM + wc * 32 + 8 * fq;
        const bool rope = (u.pn < 20) && (u.pm >= 32);
        const bool kout = (u.pm < 32) && (u.pn >= 16) && (u.pn < 20);
        const bool vout = (u.pm < 32) && (u.pn >= 20) && (u.pn < 24);
#pragma unroll
        for (int ai = 0; ai < 2; ++ai)
#pragma unroll
            for (int m = 0; m < 4; ++m) {
                const int row = row0 + ai * HALF + m * 16;
                f32x4 cs = (f32x4){1.f, 1.f, 1.f, 1.f}, sn = (f32x4){0.f, 0.f, 0.f, 0.f};
                if (rope) { const int pos = (row - NCTX) & 2047; cs = *(const f32x4*)(rcos + pos * 64 + 16 * wc + 4 * fq); sn = *(const f32x4*)(rsin + pos * 64 + 16 * wc + 4 * fq); }
                bf16_t* rowp = P + (size_t)row * INW + col0;
#pragma unroll
                for (int bj = 0; bj < 2; ++bj) {
                    f32x4 v0 = acc[ai][bj][m][0], v1 = acc[ai][bj][m][1];
                    if (kout) { float* kp = newk + (size_t)row * KVW + (u.pn - 16) * 256 + bj * HALF + 64 * (wc >> 1) + 16 * (wc & 1) + 4 * fq; *(f32x4*)kp = v0; *(f32x4*)(kp + 32) = v1; }
                    if (vout) { float* vp = newv + (size_t)row * KVW + (u.pn - 20) * 256 + bj * HALF + wc * 32 + 8 * fq; *(f32x4*)vp = v0; *(f32x4*)(vp + 4) = v1; }
                    if (rope) { const f32x4 o0 = v0 * cs - v1 * sn, o1 = v0 * sn + v1 * cs; v0 = o0; v1 = o1; }
                    __builtin_nontemporal_store(pack8(v0, v1), (u32x4*)(rowp + bj * HALF));
                }
            }
    }
};


struct EpiIn8 {
    typedef i32x4 acc_t;
    static constexpr bool PERM = true, HAS_MID = false;
    bf16_t* P; const float* sa; const float* sb; const float* rcos; const float* rsin;
    __device__ __forceinline__ void mid(i32x4 (&)[2][2][4][2], const Unit&, int, int, int, int) const {}
    __device__ __forceinline__ void operator()(const i32x4 (&acc)[2][2][4][2], const Unit& u, int wr, int wc, int fr_, int fq_) const {
        int fr = fr_, fq = fq_; asm volatile("" : "+v"(fr), "+v"(fq));
        const int row0 = u.pm * BM + wr * 64 + fr, col0 = u.pn * BM + wc * 32 + 8 * fq, bcol0 = u.pnb * BM + wc * 32 + 8 * fq;
        const bool rope = (u.pn < 16) && (u.pm >= 32);
        f32x4 cb[2][2];
#pragma unroll
        for (int bj = 0; bj < 2; ++bj)
#pragma unroll
            for (int n = 0; n < 2; ++n) cb[bj][n] = *(const f32x4*)(sb + bcol0 + bj * HALF + 4 * n);
#pragma unroll
        for (int ai = 0; ai < 2; ++ai)
#pragma unroll
            for (int m = 0; m < 4; ++m) {
                const int row = row0 + ai * HALF + m * 16; const float ra = sa[row];
                f32x4 cs = (f32x4){1.f, 1.f, 1.f, 1.f}, sn = (f32x4){0.f, 0.f, 0.f, 0.f};
                if (rope) { const int pos = (row - NCTX) & 2047; cs = *(const f32x4*)(rcos + pos * 64 + 16 * wc + 4 * fq); sn = *(const f32x4*)(rsin + pos * 64 + 16 * wc + 4 * fq); }
                bf16_t* rowp = P + (size_t)row * INW + col0;
#pragma unroll
                for (int bj = 0; bj < 2; ++bj) {
                    f32x4 v0 = __builtin_convertvector(acc[ai][bj][m][0], f32x4) * cb[bj][0] * ra, v1 = __builtin_convertvector(acc[ai][bj][m][1], f32x4) * cb[bj][1] * ra;
                    if (rope) { const f32x4 o0 = v0 * cs - v1 * sn, o1 = v0 * sn + v1 * cs; v0 = o0; v1 = o1; }
                    __builtin_nontemporal_store(pack8(v0, v1), (u32x4*)(rowp + bj * HALF));
                }
            }
    }
};

struct EpiMerge {
    typedef f32x4 acc_t;
    static constexpr bool PERM = true, HAS_MID = true;
    const bf16_t* P; bf16_t* O;
    __device__ __forceinline__ void mid(f32x4 (&acc)[2][2][4][2], const Unit& u, int wr, int wc, int fr_, int fq_) const {
        int fr = fr_, fq = fq_; asm volatile("" : "+v"(fr), "+v"(fq));
        const int row0 = u.pm * BM + wr * 64 + fr, col0 = u.pn * BM + wc * 32 + 8 * fq;
#pragma unroll
        for (int ai = 0; ai < 2; ++ai)
#pragma unroll
            for (int m = 0; m < 4; ++m) { const bf16_t* gp = P + (size_t)(row0 + ai * HALF + m * 16) * INW + col0;
#pragma unroll
                for (int bj = 0; bj < 2; ++bj) {
                    const u32x4 ga = *(const u32x4*)(gp + C_GA + bj * HALF), gc = *(const u32x4*)(gp + C_GC + bj * HALF);
#pragma unroll
                    for (int e = 0; e < 4; ++e) {
                        const float a0 = bf_lo(ga[e]), a1 = bf_hi(ga[e]), c0 = bf_lo(gc[e]), c1 = bf_hi(gc[e]);
                        const float r0 = (1.f + __expf(-c0)) * __builtin_amdgcn_rcpf(1.f + __expf(-a0)), r1 = (1.f + __expf(-c1)) * __builtin_amdgcn_rcpf(1.f + __expf(-a1));
                        acc[ai][bj][m][e >> 1][(e & 1) * 2] *= r0; acc[ai][bj][m][e >> 1][(e & 1) * 2 + 1] *= r1;
                    }
                }
                if (m == 3) asm volatile("" ::: "memory");
            }
    }
    __device__ __forceinline__ void operator()(const f32x4 (&acc)[2][2][4][2], const Unit& u, int wr, int wc, int fr_, int fq_) const {
        int fr = fr_, fq = fq_; asm volatile("" : "+v"(fr), "+v"(fq));
        const int row0 = u.pm * BM + wr * 64 + fr, col0 = u.pn * BM + wc * 32 + 8 * fq;
#pragma unroll
        for (int ai = 0; ai < 2; ++ai)
#pragma unroll
            for (int m = 0; m < 4; ++m) { const int row = row0 + ai * HALF + m * 16; const bf16_t* gp = P + (size_t)row * INW + col0 + C_GC; bf16_t* rowp = O + (size_t)row * DM + col0;
#pragma unroll
                for (int bj = 0; bj < 2; ++bj) {
                    const u32x4 gc = *(const u32x4*)(gp + bj * HALF);
                    f32x4 v0 = acc[ai][bj][m][0], v1 = acc[ai][bj][m][1];
                    v0[0] *= __builtin_amdgcn_rcpf(1.f + __expf(-bf_lo(gc[0]))); v0[1] *= __builtin_amdgcn_rcpf(1.f + __expf(-bf_hi(gc[0])));
                    v0[2] *= __builtin_amdgcn_rcpf(1.f + __expf(-bf_lo(gc[1]))); v0[3] *= __builtin_amdgcn_rcpf(1.f + __expf(-bf_hi(gc[1])));
                    v1[0] *= __builtin_amdgcn_rcpf(1.f + __expf(-bf_lo(gc[2]))); v1[1] *= __builtin_amdgcn_rcpf(1.f + __expf(-bf_hi(gc[2])));
                    v1[2] *= __builtin_amdgcn_rcpf(1.f + __expf(-bf_lo(gc[3]))); v1[3] *= __builtin_amdgcn_rcpf(1.f + __expf(-bf_hi(gc[3])));
                    *(u32x4*)(rowp + bj * HALF) = pack8(v0, v1);
                }
            }
    }
};


struct EpiT1 {
    typedef i32x4 acc_t;
    static constexpr bool PERM = true, HAS_MID = false;
    const bf16_t* P; bf16_t* O; const float* sa; const float* sb;
    __device__ __forceinline__ void mid(i32x4 (&)[2][2][4][2], const Unit&, int, int, int, int) const {}
    __device__ __forceinline__ void operator()(const i32x4 (&acc)[2][2][4][2], const Unit& u, int wr, int wc, int fr_, int fq_) const {
        int fr = fr_, fq = fq_; asm volatile("" : "+v"(fr), "+v"(fq));
        const int row0 = u.pm * BM + wr * 64 + fr, col0 = u.pn * BM + wc * 32 + 8 * fq;
        f32x4 cb[2][2];
#pragma unroll
        for (int bj = 0; bj < 2; ++bj)
#pragma unroll
            for (int n = 0; n < 2; ++n) cb[bj][n] = *(const f32x4*)(sb + col0 + bj * HALF + 4 * n);
#pragma unroll
        for (int ai = 0; ai < 2; ++ai)
#pragma unroll
            for (int m = 0; m < 4; ++m) { const int row = row0 + ai * HALF + m * 16; const float ra = sa[row]; const bf16_t* gp = P + (size_t)row * INW + col0 + C_GA; bf16_t* rowp = O + (size_t)row * DM + col0;
#pragma unroll
                for (int bj = 0; bj < 2; ++bj) {
                    const u32x4 ga = __builtin_nontemporal_load((const u32x4*)(gp + bj * HALF));
                    f32x4 v0 = __builtin_convertvector(acc[ai][bj][m][0], f32x4) * cb[bj][0] * ra, v1 = __builtin_convertvector(acc[ai][bj][m][1], f32x4) * cb[bj][1] * ra;
                    v0[0] *= __builtin_amdgcn_rcpf(1.f + __expf(-bf_lo(ga[0]))); v0[1] *= __builtin_amdgcn_rcpf(1.f + __expf(-bf_hi(ga[0])));
                    v0[2] *= __builtin_amdgcn_rcpf(1.f + __expf(-bf_lo(ga[1]))); v0[3] *= __builtin_amdgcn_rcpf(1.f + __expf(-bf_hi(ga[1])));
                    v1[0] *= __builtin_amdgcn_rcpf(1.f + __expf(-bf_lo(ga[2]))); v1[1] *= __builtin_amdgcn_rcpf(1.f + __expf(-bf_hi(ga[2])));
                    v1[2] *= __builtin_amdgcn_rcpf(1.f + __expf(-bf_lo(ga[3]))); v1[3] *= __builtin_amdgcn_rcpf(1.f + __expf(-bf_hi(ga[3])));
                    *(u32x4*)(rowp + bj * HALF) = pack8(v0, v1);
                }
            }
    }
};
struct EpiMerge2 {
    typedef f32x4 acc_t;
    static constexpr bool PERM = true, HAS_MID = false;
    const bf16_t* P; bf16_t* O;
    __device__ __forceinline__ void mid(f32x4 (&)[2][2][4][2], const Unit&, int, int, int, int) const {}
    __device__ __forceinline__ void operator()(const f32x4 (&acc)[2][2][4][2], const Unit& u, int wr, int wc, int fr_, int fq_) const {
        int fr = fr_, fq = fq_; asm volatile("" : "+v"(fr), "+v"(fq));
        const int row0 = u.pm * BM + wr * 64 + fr, col0 = u.pn * BM + wc * 32 + 8 * fq;
#pragma unroll
        for (int ai = 0; ai < 2; ++ai)
#pragma unroll
            for (int m = 0; m < 4; ++m) { const int row = row0 + ai * HALF + m * 16; const bf16_t* gp = P + (size_t)row * INW + col0 + C_GC; bf16_t* rowp = O + (size_t)row * DM + col0;
#pragma unroll
                for (int bj = 0; bj < 2; ++bj) {
                    const u32x4 gc = __builtin_nontemporal_load((const u32x4*)(gp + bj * HALF)), tp = *(const u32x4*)(rowp + bj * HALF);
                    f32x4 v0 = acc[ai][bj][m][0], v1 = acc[ai][bj][m][1];
                    v0[0] = bf_lo(tp[0]) + v0[0] * __builtin_amdgcn_rcpf(1.f + __expf(-bf_lo(gc[0]))); v0[1] = bf_hi(tp[0]) + v0[1] * __builtin_amdgcn_rcpf(1.f + __expf(-bf_hi(gc[0])));
                    v0[2] = bf_lo(tp[1]) + v0[2] * __builtin_amdgcn_rcpf(1.f + __expf(-bf_lo(gc[1]))); v0[3] = bf_hi(tp[1]) + v0[3] * __builtin_amdgcn_rcpf(1.f + __expf(-bf_hi(gc[1])));
                    v1[0] = bf_lo(tp[2]) + v1[0] * __builtin_amdgcn_rcpf(1.f + __expf(-bf_lo(gc[2]))); v1[1] = bf_hi(tp[2]) + v1[1] * __builtin_amdgcn_rcpf(1.f + __expf(-bf_hi(gc[2])));
                    v1[2] = bf_lo(tp[3]) + v1[2] * __builtin_amdgcn_rcpf(1.f + __expf(-bf_lo(gc[3]))); v1[3] = bf_hi(tp[3]) + v1[3] * __builtin_amdgcn_rcpf(1.f + __expf(-bf_hi(gc[3])));
                    *(u32x4*)(rowp + bj * HALF) = pack8(v0, v1);
                }
            }
    }
};

struct EpiVal {
    typedef i32x4 acc_t;
    static constexpr bool PERM = true, HAS_MID = false;
    bf16_t* V; const float* sa; const float* sb;
    __device__ __forceinline__ void mid(i32x4 (&)[2][2][4][2], const Unit&, int, int, int, int) const {}
    __device__ __forceinline__ void operator()(const i32x4 (&acc)[2][2][4][2], const Unit& u, int wr, int wc, int fr_, int fq_) const {
        int fr = fr_, fq = fq_; asm volatile("" : "+v"(fr), "+v"(fq));
        const int row0 = u.pm * BM + wr * 64 + fr, col0 = u.pn * BM + wc * 32 + 8 * fq;
        f32x4 cb[2][2];
#pragma unroll
        for (int bj = 0; bj < 2; ++bj)
#pragma unroll
            for (int n = 0; n < 2; ++n) cb[bj][n] = *(const f32x4*)(sb + col0 + bj * HALF + 4 * n);
#pragma unroll
        for (int ai = 0; ai < 2; ++ai)
#pragma unroll
            for (int m = 0; m < 4; ++m) { const int row = row0 + ai * HALF + m * 16; const float ra = sa[row]; bf16_t* rowp = V + (size_t)row * DFF + col0;
#pragma unroll
                for (int bj = 0; bj < 2; ++bj) __builtin_nontemporal_store(pack8(__builtin_convertvector(acc[ai][bj][m][0], f32x4) * cb[bj][0] * ra, __builtin_convertvector(acc[ai][bj][m][1], f32x4) * cb[bj][1] * ra), (u32x4*)(rowp + bj * HALF)); }
    }
};
struct EpiUp {
    typedef f32x4 acc_t;
    static constexpr bool PERM = true, HAS_MID = false;
    bf16_t* F; const bf16_t* VAL; const float* wconv; float* sbg; PG8_LAS float* halo;
    __device__ __forceinline__ void mid(f32x4 (&)[2][2][4][2], const Unit&, int, int, int, int) const {}
    __device__ __forceinline__ void operator()(const f32x4 (&acc)[2][2][4][2], const Unit& u, int wr, int wc, int fr_, int fq_) const {
        int fr = fr_, fq = fq_; asm volatile("" : "+v"(fr), "+v"(fq));
        const int colh = wc * 32 + 8 * fq, ch0 = u.pn * 256 + colh;
#pragma unroll
        for (int ai = 0; ai < 2; ++ai) { const int sp = 2 * ai + wr;
#pragma unroll
            for (int bj = 0; bj < 2; ++bj) {
                if (fr == 0)  { *(PG8_LAS f32x4*)(halo + (0 * 4 + sp) * 256 + bj * HALF + colh) = acc[ai][bj][0][0]; *(PG8_LAS f32x4*)(halo + (0 * 4 + sp) * 256 + bj * HALF + colh + 4) = acc[ai][bj][0][1]; }
                if (fr == 15) { *(PG8_LAS f32x4*)(halo + (1 * 4 + sp) * 256 + bj * HALF + colh) = acc[ai][bj][3][0]; *(PG8_LAS f32x4*)(halo + (1 * 4 + sp) * 256 + bj * HALF + colh + 4) = acc[ai][bj][3][1]; } } }
        asm volatile("s_waitcnt lgkmcnt(0)" ::: "memory"); __builtin_amdgcn_s_barrier(); asm volatile("" ::: "memory");
        if (u.pm >= 32) {
#pragma unroll
            for (int bj = 0; bj < 2; ++bj) {
                if (wr == 0 && fr < 2) { float* p = sbg + ((size_t)u.pm * 4 + fr) * DFF + ch0 + bj * HALF; *(f32x4*)p = acc[0][bj][0][0]; *(f32x4*)(p + 4) = acc[0][bj][0][1]; }
                if (wr == 1 && fr >= 14) { float* p = sbg + ((size_t)u.pm * 4 + 2 + (fr - 14)) * DFF + ch0 + bj * HALF; *(f32x4*)p = acc[1][bj][3][0]; *(f32x4*)(p + 4) = acc[1][bj][3][1]; } }
        }
#define DPP_F(oldv, srcv, ctrl) __builtin_bit_cast(float, __builtin_amdgcn_update_dpp(__builtin_bit_cast(int, (float)(oldv)), __builtin_bit_cast(int, (float)(srcv)), (ctrl), 0xf, 0xf, false))
#pragma unroll
        for (int bj = 0; bj < 2; ++bj) {
            f32x4 w0[2], w1[2], w2[2];
#pragma unroll
            for (int n = 0; n < 2; ++n) { const float* wp = wconv + ch0 + bj * HALF + 4 * n; w0[n] = *(const f32x4*)wp; w1[n] = *(const f32x4*)(wp + DFF); w2[n] = *(const f32x4*)(wp + 2 * DFF); }
#pragma unroll
            for (int ai = 0; ai < 2; ++ai) { const int sp = 2 * ai + wr;
                f32x4 hup[2], hdn[2];
#pragma unroll
                for (int n = 0; n < 2; ++n) {
                    hup[n] = (sp > 0) ? *(const PG8_LAS f32x4*)(halo + (1 * 4 + sp - 1) * 256 + bj * HALF + colh + 4 * n) : (f32x4){0.f, 0.f, 0.f, 0.f};
                    hdn[n] = (sp < 3) ? *(const PG8_LAS f32x4*)(halo + (0 * 4 + sp + 1) * 256 + bj * HALF + colh + 4 * n) : (f32x4){0.f, 0.f, 0.f, 0.f}; }
#pragma unroll
                for (int m = 0; m < 4; ++m) {
                    const size_t off = (size_t)(u.pm * BM + ai * HALF + wr * 64 + m * 16 + fr) * DFF + ch0 + bj * HALF;
                    const u32x4 vp = __builtin_nontemporal_load((const u32x4*)(VAL + off));
                    f32x4 o[2];
#pragma unroll
                    for (int n = 0; n < 2; ++n)
#pragma unroll
                        for (int j = 0; j < 4; ++j) {
                            const float g = acc[ai][bj][m][n][j];
                            float ub, db;
                            if (m > 0) ub = DPP_F(0.f, acc[ai][bj][m > 0 ? m - 1 : 0][n][j], 0x121); else ub = hup[n][j];
                            if (m < 3) db = DPP_F(0.f, acc[ai][bj][m < 3 ? m + 1 : 3][n][j], 0x12f); else db = hdn[n][j];
                            const float up = DPP_F(ub, g, 0x111), dn = DPP_F(db, g, 0x101);
                            const float cv = w0[n][j] * up + w1[n][j] * g + w2[n][j] * dn;
                            const unsigned vw = vp[2 * n + (j >> 1)]; const float vl = (j & 1) ? bf_hi(vw) : bf_lo(vw);
                            o[n][j] = cv * __builtin_amdgcn_rcpf(1.f + __expf(-cv)) * vl;
                        }
                    __builtin_nontemporal_store(pack8(o[0], o[1]), (u32x4*)(F + off));
                }
            }
        }
#undef DPP_F
    }
};

template <class Epi, class Sched, bool ALIGN_EPI, bool I8 = false>
__device__ __forceinline__ void gemm_phase(PG8_LAS unsigned char* lds, const Gemm g, const Sched& S, const Epi& E, const int tid) {
    typedef typename Epi::acc_t acc_t;
    const int wid = __builtin_amdgcn_readfirstlane(tid >> 6), lane = tid & 63, wr = wid >> 2, wc = wid & 3, fr = lane & 15, fq = lane >> 4;
    const int K = g.K, rbA = I8 ? g.lda : g.lda * 2, rbB = I8 ? K : K * 2, nt = rbB / (BK * 2);
    unsigned voffA[2], voffB[2];
#pragma unroll
    for (int i = 0; i < 2; ++i) { int R, C; stage_rc(tid * 16 + i * 8192, R, C); const int Rb = Epi::PERM ? ((R & ~31) + perm32(R & 31)) : R;
        voffA[i] = (unsigned)(R * rbA + C * 2); voffB[i] = (unsigned)(Rb * rbB + C * 2); }
    const size_t kstep = (size_t)(BK * 2);
    const size_t hstepA = (size_t)HALF * rbA, hstepB = (size_t)HALF * rbB;
    const size_t tstepA = 2 * hstepA, tstepB = 2 * hstepB;
    const unsigned ldsw = (unsigned)wid * 1024u;
    const int aoff = lds_byte(wr * 64 + fr, fq * 8), boff = lds_byte(wc * 32 + fr, fq * 8);
#define PG8_KOFF(kt) ((size_t)(kt) * kstep + (((kt) >= g.kj_t) ? (size_t)g.kj_bytes : (size_t)0))
#define PG8_SA(b, h) (((b) * 2 + (h)) * HTB)
#define PG8_SB(b, h) ((4 + (b) * 2 + (h)) * HTB)
#define PG8_STAGE(bufoff, gbase, voff) do { _Pragma("unroll") for (int _i = 0; _i < 2; ++_i) \
        __builtin_amdgcn_global_load_lds((const unsigned*)((const char*)(gbase) + (voff)[_i]), (PG8_LAS unsigned*)(lds + (bufoff) + ldsw + _i * 8192), 16, 0, 0); } while (0)
#define PG8_LDA(dst, b, h) do { _Pragma("unroll") for (int m = 0; m < 4; ++m) _Pragma("unroll") for (int k = 0; k < 2; ++k) dst[m][k] = *(const PG8_LAS bf16x8*)(lds + PG8_SA(b, h) + aoff + m * 2048 + k * 1024); } while (0)
#define PG8_LDB(dst, b, h) do { _Pragma("unroll") for (int n = 0; n < 2; ++n) _Pragma("unroll") for (int k = 0; k < 2; ++k) dst[n][k] = *(const PG8_LAS bf16x8*)(lds + PG8_SB(b, h) + boff + n * 2048 + k * 1024); } while (0)
#define PG8_MMA(ai, bj, At, Bt) do { __builtin_amdgcn_s_setprio(1); _Pragma("unroll") for (int m = 0; m < 4; ++m) _Pragma("unroll") for (int n = 0; n < 2; ++n) _Pragma("unroll") for (int k = 0; k < 2; ++k) { \
        if constexpr (I8) acc[ai][bj][m][n] = __builtin_amdgcn_mfma_i32_16x16x64_i8(__builtin_bit_cast(i32x4, Bt[n][k]), __builtin_bit_cast(i32x4, At[m][k]), acc[ai][bj][m][n], 0, 0, 0); \
        else acc[ai][bj][m][n] = __builtin_amdgcn_mfma_f32_16x16x32_bf16(Bt[n][k], At[m][k], acc[ai][bj][m][n], 0, 0, 0); } __builtin_amdgcn_s_setprio(0); } while (0)
#define PG8_WAIT_V(n) asm volatile("s_waitcnt vmcnt(" #n ")" ::: "memory")
#define PG8_WAIT_L(n) asm volatile("s_waitcnt lgkmcnt(" #n ")" ::: "memory")
#define PG8_BAR __builtin_amdgcn_s_barrier()
#define PG8_SCHED __builtin_amdgcn_sched_barrier(0)
    Unit cur, nxt; int ui = 0;
    if (!S.next(0, cur)) return;
    acc_t acc[2][2][4][2];
#pragma unroll
    for (int a = 0; a < 2; ++a)
#pragma unroll
        for (int b = 0; b < 2; ++b)
#pragma unroll
            for (int m = 0; m < 4; ++m)
#pragma unroll
                for (int n = 0; n < 2; ++n) acc[a][b][m][n] = (acc_t){0, 0, 0, 0};
    bf16x8 At[4][2], B0[2][2], B1[2][2];
    const char* cA = (const char*)g.A + (size_t)cur.pm * tstepA; const char* cB = (const char*)g.Bt + (size_t)cur.pnb * tstepB;
    S.a_ready(cur);
    PG8_STAGE(PG8_SB(0, 0), cB, voffB); PG8_STAGE(PG8_SB(0, 1), cB + hstepB, voffB); PG8_STAGE(PG8_SA(0, 0), cA, voffA); PG8_STAGE(PG8_SA(0, 1), cA + hstepA, voffA);
    if (wr == 1) PG8_BAR;
    PG8_WAIT_V(2); PG8_BAR;
    PG8_STAGE(PG8_SB(1, 0), cB + kstep, voffB); PG8_STAGE(PG8_SA(1, 0), cA + kstep, voffA); PG8_STAGE(PG8_SB(1, 1), cB + hstepB + kstep, voffB);
    PG8_WAIT_V(6); PG8_BAR;
    for (;;) {
        const bool has_next = S.next(ui + 1, nxt);
        const char* nA = has_next ? (const char*)g.A + (size_t)nxt.pm * tstepA : cA; const char* nB = has_next ? (const char*)g.Bt + (size_t)nxt.pnb * tstepB : cB;
        for (int t = 0; t < nt; t += 2) {
            const bool last = (t == nt - 2);
            if constexpr (Epi::HAS_MID) { if (t == g.kj_t) E.mid(acc, cur, wr, wc, fr, fq); }
            const char* a1 = cA + PG8_KOFF(t + 1);
            const char* a2 = last ? nA : cA + PG8_KOFF(t + 2); const char* b2 = last ? nB : cB + (size_t)(t + 2) * kstep;
            const char* a3 = a2 + kstep; const char* b3 = b2 + kstep;
            if (last && has_next) S.a_ready(nxt);
            PG8_LDB(B0, 0, 0); PG8_LDB(B1, 0, 1); PG8_SCHED; PG8_LDA(At, 0, 0); PG8_STAGE(PG8_SA(1, 1), a1 + hstepA, voffA);
            PG8_WAIT_V(8); PG8_WAIT_L(0); PG8_BAR; PG8_MMA(0, 0, At, B0); PG8_MMA(0, 1, At, B1); PG8_BAR; PG8_SCHED;
            PG8_LDA(At, 0, 1); PG8_STAGE(PG8_SB(0, 0), b2, voffB); PG8_STAGE(PG8_SB(0, 1), b2 + hstepB, voffB); PG8_STAGE(PG8_SA(0, 0), a2, voffA);
            PG8_WAIT_V(8); PG8_WAIT_L(0); PG8_BAR; PG8_MMA(1, 0, At, B0); PG8_MMA(1, 1, At, B1); PG8_BAR; PG8_SCHED;
            PG8_LDB(B0, 1, 0); PG8_LDB(B1, 1, 1); PG8_SCHED; PG8_LDA(At, 1, 0); PG8_STAGE(PG8_SA(0, 1), a2 + hstepA, voffA);
            PG8_WAIT_V(8); PG8_WAIT_L(0); PG8_BAR; PG8_MMA(0, 0, At, B0); PG8_MMA(0, 1, At, B1); PG8_BAR; PG8_SCHED;
            PG8_LDA(At, 1, 1); PG8_STAGE(PG8_SB(1, 0), b3, voffB); PG8_STAGE(PG8_SB(1, 1), b3 + hstepB, voffB); PG8_STAGE(PG8_SA(1, 0), a3, voffA);
            PG8_WAIT_V(8); PG8_WAIT_L(0); PG8_BAR; PG8_MMA(1, 0, At, B0); PG8_MMA(1, 1, At, B1); PG8_BAR; PG8_SCHED;
        }
        if constexpr (ALIGN_EPI) { if (wr == 0) PG8_BAR; }
        E(acc, cur, wr, wc, fr, fq); S.done(cur);
        if (!has_next) break;
#pragma unroll
        for (int a = 0; a < 2; ++a)
#pragma unroll
            for (int b = 0; b < 2; ++b)
#pragma unroll
                for (int m = 0; m < 4; ++m)
#pragma unroll
                    for (int n = 0; n < 2; ++n) acc[a][b][m][n] = (acc_t){0, 0, 0, 0};
        cur = nxt; cA = nA; cB = nB; ++ui;
        if constexpr (ALIGN_EPI) { if (wr == 1) PG8_BAR; }
    }
    PG8_WAIT_V(0);
    if constexpr (!ALIGN_EPI) { if (wr == 0) PG8_BAR; }
    PG8_BAR;
#undef PG8_KOFF
#undef PG8_SA
#undef PG8_SB
#undef PG8_STAGE
#undef PG8_LDA
#undef PG8_LDB
#undef PG8_MMA
#undef PG8_WAIT_V
#undef PG8_WAIT_L
#undef PG8_BAR
#undef PG8_SCHED
}
}

namespace att {
typedef unsigned short bf16_t;
using bf16x8 = __attribute__((ext_vector_type(8))) short;
using s16x4  = __attribute__((ext_vector_type(4))) short;
using f32x16 = __attribute__((ext_vector_type(16))) float;
using u32x4  = __attribute__((ext_vector_type(4))) unsigned;
constexpr int D = 128, KVBLK = 64;
constexpr float SCALE = 0.088388347648318440f, THR = 8.f;
constexpr int SHM_V = KVBLK * D * 2, SHM_K = KVBLK * D * 2, SHM_ATTN = 2 * SHM_V + 2 * SHM_K + 8 * 64 * 4;
#define KSWZ(row, colB) ((row) * 256 + ((colB) ^ (((row) & 7) << 4)))
#define SBAR() __builtin_amdgcn_sched_barrier(0)
__device__ __forceinline__ int crow(int r, int hi) { return (r & 3) + 8 * (r >> 2) + 4 * hi; }
__device__ __forceinline__ unsigned cvtpk(float lo, float hi) { unsigned r; asm volatile("v_cvt_pk_bf16_f32 %0, %1, %2" : "=v"(r) : "v"(lo), "v"(hi)); return r; }
__device__ __forceinline__ bf16x8 ld8(const bf16_t* p) { return *reinterpret_cast<const bf16x8*>(p); }

__device__ __forceinline__ void partialSM(f32x16& p0, f32x16& p1, float& m_reg, float& mn, float& alpha) {
  constexpr float C = SCALE * 1.4426950408889634f;
  float pmax = p0[0];
#pragma unroll
  for (int r = 1; r < 16; ++r) pmax = fmaxf(pmax, p0[r]);
#pragma unroll
  for (int r = 0; r < 16; ++r) pmax = fmaxf(pmax, p1[r]);
  { auto rr = __builtin_amdgcn_permlane32_swap(__float_as_uint(pmax), __float_as_uint(pmax), false, false);
    pmax = fmaxf(__uint_as_float(rr[0]), __uint_as_float(rr[1])); }
  if (__builtin_expect(__all(pmax - m_reg <= THR / SCALE), 1)) { mn = m_reg; alpha = 1.f; }
  else { mn = fmaxf(m_reg, pmax); alpha = __builtin_amdgcn_exp2f((m_reg - mn) * C); m_reg = mn; }
  float mnC = -mn * C;
#pragma unroll
  for (int r = 0; r < 16; ++r) p0[r] = fmaf(p0[r], C, mnC);
#pragma unroll
  for (int r = 0; r < 16; ++r) p1[r] = fmaf(p1[r], C, mnC);
#pragma unroll
  for (int r = 0; r < 16; ++r) p0[r] = __builtin_amdgcn_exp2f(p0[r]);
}
__device__ __forceinline__ void finishSM(f32x16& p0, f32x16& p1, float alpha, float& l_reg, bf16x8& pa0, bf16x8& pa1, bf16x8& pa2, bf16x8& pa3) {
#pragma unroll
  for (int r = 0; r < 16; ++r) p1[r] = __builtin_amdgcn_exp2f(p1[r]);
  float ps = 0;
#pragma unroll
  for (int r = 0; r < 16; ++r) ps += p0[r];
#pragma unroll
  for (int r = 0; r < 16; ++r) ps += p1[r];
  { auto rr = __builtin_amdgcn_permlane32_swap(__float_as_uint(ps), __float_as_uint(ps), false, false);
    ps = __uint_as_float(rr[0]) + __uint_as_float(rr[1]); }
  l_reg = l_reg * alpha + ps;
#define PK4(P, BASE, OUT) do { unsigned a0 = cvtpk(P[BASE + 0], P[BASE + 1]), a1 = cvtpk(P[BASE + 2], P[BASE + 3]);   \
    unsigned b0 = cvtpk(P[BASE + 4], P[BASE + 5]), b1 = cvtpk(P[BASE + 6], P[BASE + 7]);                              \
    auto r0 = __builtin_amdgcn_permlane32_swap(a0, b0, false, false); auto r1 = __builtin_amdgcn_permlane32_swap(a1, b1, false, false); \
    u32x4 w = {r0[0], r1[0], r0[1], r1[1]}; OUT = *reinterpret_cast<bf16x8*>(&w); } while (0)
  PK4(p0, 0, pa0); PK4(p0, 8, pa1); PK4(p1, 0, pa2); PK4(p1, 8, pa3);
#undef PK4
}
__device__ __forceinline__ void qkt(f32x16& p0, f32x16& p1, const char* Ks, const bf16x8* qr, int r32, int hi) {
  p0 = f32x16{}; p1 = f32x16{};
#pragma unroll
  for (int d0 = 0; d0 < 8; ++d0) { int cb = (d0 * 16 + hi * 8) * 2;
    bf16x8 b0 = *reinterpret_cast<const bf16x8*>(Ks + KSWZ(r32, cb));
    bf16x8 b1 = *reinterpret_cast<const bf16x8*>(Ks + KSWZ(32 + r32, cb));
    p0 = __builtin_amdgcn_mfma_f32_32x32x16_bf16(b0, qr[d0], p0, 0, 0, 0);
    p1 = __builtin_amdgcn_mfma_f32_32x32x16_bf16(b1, qr[d0], p1, 0, 0, 0); }
}
__device__ __forceinline__ int v_st(int k, int c) { const int kk = (k & ~0xC) | ((k & 4) << 1) | ((k & 8) >> 1); return ((kk >> 3) * 4 + (c >> 5)) * 512 + ((kk & 7) * 32 + (c & 31)) * 2; }
__device__ __forceinline__ int v_rd_base(int lane) { return ((lane & 3) << 3) | (((lane >> 2) & 3) << 6) | (((lane >> 4) & 1) << 5) | (((lane >> 5) & 1) << 8); }
constexpr int v_rd_off(int d0, int ks, int half) { return d0 * 512 + ks * 4096 + half * 2048; }
template <int OFF> __device__ __forceinline__ s16x4 tr_read(int vb) {
  s16x4 r; asm volatile("ds_read_b64_tr_b16 %0, %1 offset:%2" : "=&v"(r) : "v"(vb), "i"(OFF) : "memory"); return r;
}
template <int D0> __device__ __forceinline__ void pv_one(f32x16& od, int vb, bf16x8 pa0, bf16x8 pa1, bf16x8 pa2, bf16x8 pa3) {
  const s16x4 l0 = tr_read<v_rd_off(D0, 0, 0)>(vb), h0 = tr_read<v_rd_off(D0, 0, 1)>(vb), l1 = tr_read<v_rd_off(D0, 1, 0)>(vb), h1 = tr_read<v_rd_off(D0, 1, 1)>(vb);
  const s16x4 l2 = tr_read<v_rd_off(D0, 2, 0)>(vb), h2 = tr_read<v_rd_off(D0, 2, 1)>(vb), l3 = tr_read<v_rd_off(D0, 3, 0)>(vb), h3 = tr_read<v_rd_off(D0, 3, 1)>(vb);
  asm volatile("s_waitcnt lgkmcnt(0)" ::: "memory"); SBAR();
#define PK(L, H) (bf16x8){L[0], L[1], L[2], L[3], H[0], H[1], H[2], H[3]}
  od = __builtin_amdgcn_mfma_f32_32x32x16_bf16(pa0, PK(l0, h0), od, 0, 0, 0);
  od = __builtin_amdgcn_mfma_f32_32x32x16_bf16(pa1, PK(l1, h1), od, 0, 0, 0);
  od = __builtin_amdgcn_mfma_f32_32x32x16_bf16(pa2, PK(l2, h2), od, 0, 0, 0);
  od = __builtin_amdgcn_mfma_f32_32x32x16_bf16(pa3, PK(l3, h3), od, 0, 0, 0);
#undef PK
}
__device__ __forceinline__ void pv_d0(f32x16* o, int vb, bf16x8 pa0, bf16x8 pa1, bf16x8 pa2, bf16x8 pa3) {
  pv_one<0>(o[0], vb, pa0, pa1, pa2, pa3); pv_one<1>(o[1], vb, pa0, pa1, pa2, pa3); pv_one<2>(o[2], vb, pa0, pa1, pa2, pa3); pv_one<3>(o[3], vb, pa0, pa1, pa2, pa3);
}
__device__ __forceinline__ void band_mask(f32x16& p0, f32x16& p1, int dq, int hi) {
#pragma unroll
  for (int r = 0; r < 16; ++r) { const int d = dq - crow(r, hi); if (d > 128 || d < -128) p0[r] = -1e30f; const int d2 = d - 32; if (d2 > 128 || d2 < -128) p1[r] = -1e30f; }
}

struct Src { const bf16_t* KA; const bf16_t* VA; int nA; const bf16_t* KB; const bf16_t* VB; int nB; int qpos0, kpos0, masked; };

__device__ __forceinline__ void attn_unit(const bf16_t* __restrict__ Qw, bf16_t* __restrict__ Ow, const Src S, float sink, char* lds, const int tid, const int ldo) {
  const int wid = tid >> 6, lane = tid & 63, r32 = lane & 31, hi = lane >> 5;
  char* V_lds = lds; char* K_lds = lds + 2 * SHM_V;
  float* ws = (float*)(lds + 2 * SHM_V + 2 * SHM_K) + wid * 64; float* li_l = ws; float* al_l = ws + 32;
  float m_reg = sink * (1.f / SCALE), l_reg = 1.f; f32x16 o[4] = {}; bf16x8 qr[8];
#pragma unroll
  for (int d0 = 0; d0 < 8; ++d0) qr[d0] = ld8(Qw + d0 * 16);
  const int sr = tid >> 4, sc = (tid & 15) * 8, vst0 = v_st(sr, sc), vst1 = v_st(32 + sr, sc);
  const int vb0 = (int)(uintptr_t)V_lds + v_rd_base(lane);
  const int qpos = S.qpos0 + 32 * (wid & 3) + r32;
  struct { bf16x8 vs0, vs1, ks0, ks1; } sr_[2];
#define SLOAD(i, t) do { const int _t = (t); const bool _a = _t < S.nA; const int _ld = _a ? KVW : INW; \
    const size_t _o = _a ? (size_t)_t * (64 * KVW) : (size_t)(_t - S.nA) * ((size_t)64 * INW); \
    const bf16_t* _k = (_a ? S.KA : S.KB) + _o + (size_t)sr * _ld + sc; const bf16_t* _v = (_a ? S.VA : S.VB) + _o + (size_t)sr * _ld + sc; \
    sr_[i].vs0 = ld8(_v); sr_[i].vs1 = ld8(_v + (size_t)32 * _ld); sr_[i].ks0 = ld8(_k); sr_[i].ks1 = ld8(_k + (size_t)32 * _ld); } while (0)
#define SWRITE(b, i) do { *(bf16x8*)(V_lds + (b) * SHM_V + vst0) = sr_[i].vs0;          \
    *(bf16x8*)(V_lds + (b) * SHM_V + vst1) = sr_[i].vs1; int kc = sc * 2;               \
    *(bf16x8*)(K_lds + (b) * SHM_K + KSWZ(sr, kc)) = sr_[i].ks0;                       \
    *(bf16x8*)(K_lds + (b) * SHM_K + KSWZ(32 + sr, kc)) = sr_[i].ks1; } while (0)
#define SWAIT() asm volatile("s_waitcnt vmcnt(4)" ::: "memory")
#define RESC(a) do { if (__any((a) < 1.f)) { if (hi == 0) al_l[r32] = (a); asm volatile("s_waitcnt lgkmcnt(0)" ::: "memory"); \
    _Pragma("unroll") for (int d = 0; d < 4; ++d) _Pragma("unroll") for (int r = 0; r < 16; ++r) o[d][r] *= al_l[crow(r, hi)]; } } while (0)
#define MASK(P0, P1, t) do { const int _t = (t); if (S.masked && _t >= S.nA) { const int _kp0 = S.kpos0 + 64 * (_t - S.nA); \
    if ((_kp0 >> 7) != (S.qpos0 >> 7)) band_mask(P0, P1, qpos - _kp0, hi); } } while (0)
  f32x16 pA0, pA1, pB0, pB1; float mnA, mnB, alA, alB; bf16x8 pa0, pa1, pa2, pa3; const int NT = S.nA + S.nB;
  constexpr int SE = 0, SO = 1;
  SLOAD(SE, 0); asm volatile("s_waitcnt vmcnt(0)" ::: "memory"); SWRITE(0, SE); __syncthreads();
  qkt(pA0, pA1, K_lds, qr, r32, hi); MASK(pA0, pA1, 0); partialSM(pA0, pA1, m_reg, mnA, alA);
  SLOAD(SO, 1); if (2 < NT) SLOAD(SE, 2);
  SWAIT(); SWRITE(1, SO); __syncthreads();
  for (int j = 1; j + 1 < NT; j += 2) {
    SBAR(); qkt(pB0, pB1, K_lds + SHM_K, qr, r32, hi);
    finishSM(pA0, pA1, alA, l_reg, pa0, pa1, pa2, pa3); SBAR();
    SLOAD(SO, j + 2); SBAR();
    pv_d0(o, vb0, pa0, pa1, pa2, pa3); MASK(pB0, pB1, j); partialSM(pB0, pB1, m_reg, mnB, alB);
    __syncthreads(); SWAIT(); SWRITE(0, SE);
    RESC(alB); __syncthreads();
    SBAR(); qkt(pA0, pA1, K_lds, qr, r32, hi);
    finishSM(pB0, pB1, alB, l_reg, pa0, pa1, pa2, pa3); SBAR();
    if (j + 3 < NT) SLOAD(SE, j + 3); SBAR();
    pv_d0(o, vb0 + (int)SHM_V, pa0, pa1, pa2, pa3); MASK(pA0, pA1, j + 1); partialSM(pA0, pA1, m_reg, mnA, alA);
    __syncthreads(); SWAIT(); SWRITE(1, SO);
    RESC(alA); __syncthreads();
  }
  SBAR(); qkt(pB0, pB1, K_lds + SHM_K, qr, r32, hi);
  finishSM(pA0, pA1, alA, l_reg, pa0, pa1, pa2, pa3); SBAR();
  pv_d0(o, vb0, pa0, pa1, pa2, pa3); MASK(pB0, pB1, NT - 1); partialSM(pB0, pB1, m_reg, mnB, alB);
  __syncthreads(); RESC(alB);
  finishSM(pB0, pB1, alB, l_reg, pa0, pa1, pa2, pa3); SBAR();
  pv_d0(o, vb0 + (int)SHM_V, pa0, pa1, pa2, pa3);
  if (hi == 0) li_l[r32] = l_reg; asm volatile("s_waitcnt lgkmcnt(0)" ::: "memory");
  float rli[16];
#pragma unroll
  for (int r = 0; r < 16; ++r) rli[r] = __builtin_amdgcn_rcpf(li_l[crow(r, hi)]);
  { char* stg = lds + SHM_ATTN + wid * 4096;
#pragma unroll
    for (int p = 0; p < 2; ++p) {
#pragma unroll
      for (int rr = 0; rr < 8; ++rr) { const int r = 8 * p + rr, lrow = (rr & 3) + 8 * (rr >> 2) + 4 * hi;
#pragma unroll
        for (int d0 = 0; d0 < 4; ++d0) *(bf16_t*)(stg + lrow * 256 + (d0 * 32 + r32) * 2) = (bf16_t)(cvtpk(o[d0][r] * rli[r], 0.f) & 0xffffu); }
      asm volatile("s_waitcnt lgkmcnt(0)" ::: "memory");
#pragma unroll
      for (int k = 0; k < 4; ++k) { const int row = 4 * k + (lane >> 4), chunk = lane & 15;
        const u32x4 v = *(const u32x4*)(stg + row * 256 + chunk * 16);
        *(u32x4*)(Ow + (size_t)(16 * p + row) * ldo + chunk * 8) = v; }
      asm volatile("s_waitcnt lgkmcnt(0)" ::: "memory");
    } }
#undef SLOAD
#undef SWRITE
#undef SWAIT
#undef RESC
#undef MASK
}
}

#ifndef MK_N_LAUNCHES
#define MK_N_LAUNCHES 1
#endif
constexpr int N_PHASES = 11;
constexpr int N_LAUNCHES = MK_N_LAUNCHES;
constexpr int NWAVES = 8;

constexpr size_t MiB = 1u << 20;
constexpr size_t WS_CTL = 0, CTL_ZERO_BYTES = 196608;
constexpr size_t WS_MOD = 1 * MiB;
constexpr size_t WS_ROPE = 2 * MiB;
constexpr size_t WS_CK = 4 * MiB, WS_CV = 12 * MiB;
constexpr size_t WS_WCAT = 20 * MiB;
constexpr size_t WS_WA8 = 36 * MiB;
constexpr size_t WS_SB3 = 52 * MiB;
constexpr size_t WS_WMIX = 68 * MiB;
constexpr size_t WS_WUP = 100 * MiB;
constexpr size_t WS_WUP8 = 186 * MiB;
constexpr size_t WS_SB2 = 229 * MiB;
constexpr size_t WS_WDN = 272 * MiB;
constexpr size_t WS_H = 358 * MiB;
constexpr size_t WS_WIN = 550 * MiB;
constexpr size_t WS_H8 = 614 * MiB;
constexpr size_t WS_PROJ = 710 * MiB;
constexpr size_t WS_VAL = WS_PROJ;
constexpr size_t WS_F = 1226 * MiB;
constexpr size_t WS_SBG = 1742 * MiB;
constexpr size_t WS_W8 = 1670 * MiB;
constexpr size_t WS_SA = 1718 * MiB, WS_SB = WS_SA + 131072;
constexpr size_t WS_END = 1760 * MiB;
static_assert(WS_WCAT + (size_t)4096 * 2048 * 2 <= WS_WA8 && WS_WA8 + (size_t)4096 * 4096 <= WS_SB3 && WS_SB3 + 4096 * 4 <= WS_WMIX && WS_WMIX + (size_t)4096 * 4096 * 2 <= WS_WUP && WS_WUP + (size_t)DFF * 4096 * 2 <= WS_WUP8 && WS_WUP8 + (size_t)DFF * 4096 <= WS_SB2 && WS_SB2 + DFF * 4 <= WS_WDN &&
              WS_WDN + (size_t)4096 * DFF * 2 <= WS_H && WS_H + (size_t)MTOT * DM * 2 <= WS_WIN && WS_WIN + (size_t)8192 * 4096 * 2 <= WS_H8 && WS_H8 + (size_t)MTOT * DM <= WS_PROJ && WS_W8 + (size_t)12288 * 4096 <= WS_SA && WS_SB + 12288 * 4 <= WS_SBG &&
              WS_PROJ + (size_t)MTOT * INW * 2 <= WS_W8 && WS_VAL + (size_t)MTOT * DFF * 2 <= WS_F && WS_F + (size_t)MTOT * DFF * 2 <= WS_SBG && WS_SBG + (size_t)96 * 4 * DFF * 4 <= WS_END && WS_CV + 8 * MiB <= WS_WCAT, "d_ws map");
constexpr int CW_BAR = 4096;
constexpr int CW_CMAX = 16384;
constexpr int CW_CMAX2 = CW_CMAX + 12288;
constexpr int CW_CMAX3 = CW_CMAX2 + 11008;
static_assert((CW_BAR + 3456) <= CW_CMAX && (CW_CMAX3 + 4096) * 4 <= (int)CTL_ZERO_BYTES, "control words inside the per-call memset");
constexpr size_t O_NK = (size_t)MTOT * DM, O_NV = O_NK + (size_t)NCTX * KVW, O_END = O_NV + (size_t)NCTX * KVW;

constexpr int RING_BYTES = 131072, MISC_OFF = RING_BYTES + 320, LDS_BYTES = 147456;

#define LAS __attribute__((address_space(3)))
typedef unsigned short bf16;
typedef float f32x4 __attribute__((ext_vector_type(4)));
typedef unsigned u32x4 __attribute__((ext_vector_type(4)));
typedef unsigned u32x2 __attribute__((ext_vector_type(2)));

#define XB_TMO      128
#define XB_XCNT(j)  (256  + 64 * (j))
#define XB_XSUB(j)  (1280 + 64 * (j))
#define XB_XGEN(j)  (2304 + 64 * (j))
#define XB_TOP      3328
#define XB_TOPGEN   3392
#define XCD_BAR_WORDS 3456
#define XB_SPIN_CAP (1u << 22)
__device__ __forceinline__ unsigned xb_ld(unsigned* p)              { return __hip_atomic_load(p, __ATOMIC_RELAXED, __HIP_MEMORY_SCOPE_AGENT); }
__device__ __forceinline__ unsigned xb_add(unsigned* p, unsigned v) { return __hip_atomic_fetch_add(p, v, __ATOMIC_RELAXED, __HIP_MEMORY_SCOPE_AGENT); }
__device__ __forceinline__ unsigned xb_xcc_id() { return (unsigned)__builtin_amdgcn_s_getreg((3 << 11) | 20) & 0xFu; }
#define XB_SPIN(cond, bar) do { unsigned _sp = 0; while (cond) { __builtin_amdgcn_s_sleep(1); \
    if ((++_sp & 255u) == 0u) { if (xb_ld(&(bar)[XB_TMO])) break; if (_sp > XB_SPIN_CAP) { atomicAdd(&(bar)[XB_TMO], 1u); break; } } } } while (0)
struct XcdBarrier { unsigned* bar; unsigned x; volatile LAS unsigned* st; };
__device__ __forceinline__ XcdBarrier xcd_barrier_post(unsigned* bar, volatile LAS unsigned* st, const int tid) {
    XcdBarrier b; b.bar = bar; b.x = xb_xcc_id(); b.st = st;
    if (tid == 0) (void)xb_add(&bar[XB_XCNT(b.x)], 1u);
    return b;
}
__device__ __forceinline__ void xcd_barrier_complete(unsigned* bar, unsigned x, unsigned& nloc, unsigned& nx) {
    const unsigned G = gridDim.x * gridDim.y * gridDim.z;
    unsigned sum, cnt, mine, sp = 0u;
    for (;;) {
        sum = 0u; cnt = 0u; mine = 0u;
#pragma unroll
        for (unsigned j = 0; j < 16; ++j) { const unsigned c = xb_ld(&bar[XB_XCNT(j)]); sum += c; cnt += (c > 0u) ? 1u : 0u; mine = (j == x) ? c : mine; }
        if (sum == G) break;
        __builtin_amdgcn_s_sleep(1);
        if ((++sp & 255u) == 0u) { if (xb_ld(&bar[XB_TMO])) break; if (sp > XB_SPIN_CAP) { atomicAdd(&bar[XB_TMO], 1u); break; } }
    }
    nloc = mine > 0u ? mine : 1u; nx = cnt > 0u ? cnt : 1u;
}
__device__ __forceinline__ void xcd_barrier(const XcdBarrier& b, const int tid) {
    asm volatile("s_waitcnt vmcnt(0)" ::: "memory");
    __syncthreads();
    if (tid == 0) {
        unsigned* bar = b.bar;
        __builtin_amdgcn_s_waitcnt(0);
        unsigned nloc = b.st[0], nx = b.st[1];
        if (nloc == 0u) { xcd_barrier_complete(bar, b.x, nloc, nx); b.st[0] = nloc; b.st[1] = nx; }
        const unsigned old = xb_add(&bar[XB_XSUB(b.x)], 1u);
        const unsigned gen = old / nloc;
        if (old + 1u == (gen + 1u) * nloc) {
            __builtin_amdgcn_fence(__ATOMIC_RELEASE, "agent");
            asm volatile("s_waitcnt vmcnt(0)" ::: "memory");
            const unsigned og = xb_add(&bar[XB_TOP], 1u);
            const unsigned tg = og / nx;
            if (og + 1u == (tg + 1u) * nx) xb_add(&bar[XB_TOPGEN], 1u);
            else XB_SPIN(xb_ld(&bar[XB_TOPGEN]) == tg, bar);
            __builtin_amdgcn_fence(__ATOMIC_ACQUIRE, "agent");
            xb_add(&bar[XB_XGEN(b.x)], 1u);
            asm volatile("s_waitcnt vmcnt(0)" ::: "memory");
        } else {
            XB_SPIN(xb_ld(&bar[XB_XGEN(b.x)]) == gen, bar);
            __builtin_amdgcn_fence(__ATOMIC_ACQUIRE, "agent");
            asm volatile("s_waitcnt vmcnt(0)" ::: "memory");
        }
    }
    __syncthreads();
}

__device__ __forceinline__ int lane_id() { int l; asm volatile("v_mbcnt_lo_u32_b32 %0, -1, 0\n\tv_mbcnt_hi_u32_b32 %0, -1, %0" : "=v"(l)); return l; }
__device__ __forceinline__ float wave_sum(float v) {
#pragma unroll
    for (int o = 1; o < 64; o <<= 1) v += __shfl_xor(v, o);
    return v;
}
__device__ __forceinline__ unsigned pk2(float lo, float hi) { return pg8::cvt_pk_bf16(lo, hi); }
__device__ __forceinline__ void unpack8(const u32x4 w, float (&f)[8]) {
#pragma unroll
    for (int e = 0; e < 4; ++e) { f[2 * e] = pg8::bf_lo(w[e]); f[2 * e + 1] = pg8::bf_hi(w[e]); }
}
__device__ __forceinline__ u32x4 pack8f(const float (&f)[8]) { u32x4 w; w.x = pk2(f[0], f[1]); w.y = pk2(f[2], f[3]); w.z = pk2(f[4], f[5]); w.w = pk2(f[6], f[7]); return w; }

struct Args { const float* in[21]; float* out; unsigned char* ws; int ph_lo, ph_hi; };
static_assert(sizeof(Args) == 21 * 8 + 8 + 8 + 8, "Args has no padding");
typedef const __attribute__((address_space(4))) Args* KA;
__device__ __forceinline__ KA launder(KA p) { asm volatile("" : "+s"(p)); return p; }
enum { I_XP = 0, I_XS, I_CK, I_CV, I_C, I_CCTX, I_WMOD, I_BMOD, I_GPREMIX, I_WIN, I_WSCONV, I_SINK, I_WAO, I_WCO, I_WMIX, I_GPOSTMIX, I_GPREFFN, I_WUP, I_WFCONV, I_WDN, I_GPOSTFFN };

__device__ __forceinline__ void p0_mod(KA a, unsigned char* lds_g, int tid, int G) {
    LAS float* sT = (LAS float*)lds_g;
    LAS float* red = (LAS float*)(lds_g + 49152);
    const float* w_mod = a->in[I_WMOD]; const float* b_mod = a->in[I_BMOD]; const float* cv = a->in[I_C]; const float* cctx = a->in[I_CCTX];
    float* mod = (float*)(a->ws + WS_MOD);
    const int cg = tid % 24, rg = tid / 24;
    for (int cbk = blockIdx.x; cbk < 256; cbk += G) {
        f32x4 acc[9];
#pragma unroll
        for (int s = 0; s < 9; ++s) acc[s] = (f32x4){0.f, 0.f, 0.f, 0.f};
        for (int kc = 0; kc < 4; ++kc) {
            __syncthreads();
            for (int idx = tid; idx < 9 * 1024; idx += NWAVES * 64) { const int s = idx >> 10, k = idx & 1023;
                const float c = (s == 0) ? cctx[kc * 1024 + k] : cv[(s - 1) * DM + kc * 1024 + k];
                sT[k * 12 + s] = c / (1.f + expf(-c)); }
            __syncthreads();
            if (tid < 504) {
                const float* wp = w_mod + (size_t)(kc * 1024) * 24576 + cbk * 96 + cg * 4;
#pragma unroll 4
                for (int kk = rg; kk < 1024; kk += 21) {
                    const f32x4 w = __builtin_nontemporal_load((const f32x4*)(wp + (size_t)kk * 24576));
                    const f32x4 s0 = *(const LAS f32x4*)(sT + kk * 12), s1 = *(const LAS f32x4*)(sT + kk * 12 + 4), s2 = *(const LAS f32x4*)(sT + kk * 12 + 8);
                    acc[0] += w * s0.x; acc[1] += w * s0.y; acc[2] += w * s0.z; acc[3] += w * s0.w;
                    acc[4] += w * s1.x; acc[5] += w * s1.y; acc[6] += w * s1.z; acc[7] += w * s1.w; acc[8] += w * s2.x;
                }
            }
        }
        if (tid < 504) {
#pragma unroll
            for (int s = 0; s < 9; ++s) *(LAS f32x4*)(red + (rg * 9 + s) * 96 + cg * 4) = acc[s];
        }
        __syncthreads();
        for (int o = tid; o < 9 * 96; o += NWAVES * 64) { const int s = o / 96, cc = o % 96; float sum = 0.f;
            for (int r2 = 0; r2 < 21; ++r2) sum += red[(r2 * 9 + s) * 96 + cc];
            const int col = cbk * 96 + cc, mi = col >> 12, c = col & 4095; float v = sum + b_mod[col];
            if (mi == 1) v = a->in[I_GPREMIX][c] * (1.f + v); else if (mi == 2) v *= a->in[I_GPOSTMIX][c]; else if (mi == 4) v = a->in[I_GPREFFN][c] * (1.f + v); else if (mi == 5) v *= a->in[I_GPOSTFFN][c];
            mod[(size_t)s * 24576 + col] = v; }
        __syncthreads();
    }
}
__device__ __forceinline__ int cvt_rowmap(int n, int rowmap) {
    if (rowmap == 1) { int r = n; if (n < 5120) { const int d = n & 127; r = (n & ~127) | ((d & 64) | ((d & 16) << 1) | ((d & 8) << 1) | ((d & 4) << 1) | ((d & 32) >> 3) | (d & 3)); }
        return r - 4096; }
    return n;
}
__device__ __forceinline__ int w8_row(int n) {
    if (n < 4096) { const int d = n & 127; return (n & ~127) | ((d & 64) | ((d & 16) << 1) | ((d & 8) << 1) | ((d & 4) << 1) | ((d & 32) >> 3) | (d & 3)); }
    return n - 8192;
}
struct CvtItem { const float* W; bf16* dst; int N, ldk, koff, kb, nb, rowmap; };
__device__ __forceinline__ CvtItem cvt_decode(KA a, int it) {
    constexpr int I_IN = 64 * 80, I_AO = 64 * 16, I_CO = 32 * 16, I_MX = 64 * 16, I_UP = 64 * 86;
    CvtItem c; int r = it, nbn; c.koff = 0; c.rowmap = 0;
    if (r < I_IN) { c.W = a->in[I_WIN]; c.N = INW; c.dst = (bf16*)(a->ws + WS_WIN); c.ldk = 4096; nbn = 80; c.rowmap = 1; }
    else if ((r -= I_IN) < I_AO) { c.W = a->in[I_WAO]; c.N = 4096; c.dst = (bf16*)(a->ws + WS_WCAT); c.ldk = 2048; nbn = 16; c.rowmap = 3; }
    else if ((r -= I_AO) < I_CO) { c.W = a->in[I_WCO]; c.N = 4096; c.dst = (bf16*)(a->ws + WS_WCAT); c.ldk = 2048; nbn = 16; }
    else if ((r -= I_CO) < I_MX) { c.W = a->in[I_WMIX]; c.N = 4096; c.dst = (bf16*)(a->ws + WS_WMIX); c.ldk = 4096; nbn = 16; }
    else if ((r -= I_MX) < I_UP) { c.W = a->in[I_WUP]; c.N = UPW; c.dst = (bf16*)(a->ws + WS_WUP); c.ldk = 4096; nbn = 86; c.rowmap = 2; }
    else { r -= I_UP; c.W = a->in[I_WDN]; c.N = 4096; c.dst = (bf16*)(a->ws + WS_WDN); c.ldk = DFF; nbn = 16; }
    c.kb = r / nbn; c.nb = r % nbn; return c;
}
#define CVT_LOAD(V, C) do { const float* _s = (C).W + (size_t)((C).kb * 64 + wave * 8) * (C).N + (C).nb * 256 + 4 * lane; \
        _Pragma("unroll") for (int j = 0; j < 8; ++j) V[j] = __builtin_nontemporal_load((const f32x4*)(_s + (size_t)j * (C).N)); } while (0)
#define CVT_PUT(V, C, T) do { _Pragma("unroll") for (int i = 0; i < 4; ++i) { u32x4 w; w.x = pk2(V[0][i], V[1][i]); w.y = pk2(V[2][i], V[3][i]); w.z = pk2(V[4][i], V[5][i]); w.w = pk2(V[6][i], V[7][i]); \
            *(LAS u32x4*)((T) + (4 * lane + i) * 144 + wave * 16) = w; } \
        __syncthreads(); \
        _Pragma("unroll") for (int q = 0; q < 4; ++q) { const int idx = q * 512 + tid, row = idx >> 3, ch = idx & 7; \
            const u32x4 w = *(const LAS u32x4*)((T) + row * 144 + ch * 16); \
            u32x4* _d = (u32x4*)((C).dst + (size_t)cvt_rowmap((C).nb * 256 + row, (C).rowmap) * (C).ldk + (C).koff + (C).kb * 64 + ch * 8); \
            if ((C).rowmap != 1) __builtin_nontemporal_store(w, _d); else *_d = w; } } while (0)
#define CVT_AMAX(V, C, T) do { f32x4 _m = (f32x4){0.f, 0.f, 0.f, 0.f}; _Pragma("unroll") for (int j = 0; j < 8; ++j) _m = __builtin_elementwise_max(_m, __builtin_elementwise_abs(V[j])); \
        *(LAS f32x4*)((T) + wave * 1024 + lane * 16) = _m; __syncthreads(); \
        if (tid < 256) { float _x = 0.f; _Pragma("unroll") for (int w_ = 0; w_ < 8; ++w_) _x = fmaxf(_x, *(const LAS float*)((T) + w_ * 1024 + tid * 4)); \
            atomicMax((unsigned*)(a->ws + WS_CTL) + ((C).rowmap == 1 ? CW_CMAX + w8_row((C).nb * 256 + tid) : (C).rowmap == 2 ? CW_CMAX2 + ((C).nb - 43) * 256 + tid : CW_CMAX3 + (C).nb * 256 + tid), __float_as_uint(_x)); } } while (0)
#define CVT_ITEM(V, C, T) do { if (((C).rowmap == 1 && ((C).nb < 16 || (C).nb >= 48)) || ((C).rowmap == 2 && (C).nb >= 43) || (C).rowmap == 3) CVT_AMAX(V, C, T); else CVT_PUT(V, C, T); } while (0)
__device__ __forceinline__ void p0_convert(KA a, int vcu, int G, int wave, int lane, int tid, int gtid, int NGT, LAS unsigned char* L) {
    constexpr int NIT = 64 * 80 + 64 * 16 + 32 * 16 + 64 * 16 + 64 * 86 + 172 * 16;
    { f32x4 va[8], vb[8]; CvtItem ca, cb; int it = vcu; LAS unsigned char* T0 = L; LAS unsigned char* T1 = L + 36864;
      __syncthreads();
      if (it < NIT) { ca = cvt_decode(a, it); CVT_LOAD(va, ca); }
      for (; it < NIT; it += 2 * G) {
          const int i2 = it + G, i3 = it + 2 * G;
          if (i2 < NIT) { cb = cvt_decode(a, i2); CVT_LOAD(vb, cb); }
          CVT_ITEM(va, ca, T0);
          if (i3 < NIT) { ca = cvt_decode(a, i3); CVT_LOAD(va, ca); }
          if (i2 < NIT) CVT_ITEM(vb, cb, T1);
      }
      __syncthreads(); }
    { const float* ck = a->in[I_CK]; const float* cvv = a->in[I_CV]; bf16* ckb = (bf16*)(a->ws + WS_CK); bf16* cvb = (bf16*)(a->ws + WS_CV);
      constexpr int NCH = 8 * PAST * KVW / 8;
      for (int i = gtid; i < 2 * NCH; i += NGT) {
          const bool isk = i < NCH; const int j = isk ? i : i - NCH; const float* s = (isk ? ck : cvv) + (size_t)j * 8;
          const f32x4 x0 = *(const f32x4*)s, x1 = *(const f32x4*)(s + 4);
          if (isk) { const int d = (j * 8) & 127; const size_t rowb = (size_t)(j * 8) & ~(size_t)127;
              const int p = (d & 64) | ((d & 16) << 1) | ((d & 8) << 1) | ((d & 32) >> 3);
              u32x2 w0, w1; w0.x = pk2(x0[0], x0[1]); w0.y = pk2(x0[2], x0[3]); w1.x = pk2(x1[0], x1[1]); w1.y = pk2(x1[2], x1[3]);
              *(u32x2*)(ckb + rowb + p) = w0; *(u32x2*)(ckb + rowb + p + 8) = w1; }
          else { u32x4 w; w.x = pk2(x0[0], x0[1]); w.y = pk2(x0[2], x0[3]); w.z = pk2(x1[0], x1[1]); w.w = pk2(x1[2], x1[3]); *(u32x4*)(cvb + (size_t)j * 8) = w; }
      } }
    { float* rc = (float*)(a->ws + WS_ROPE); float* rs = rc + 2048 * 64;
      for (int i = gtid; i < 2048 * 64; i += NGT) { const int pos = i >> 6, af = i & 63, axis = af >> 5, f = af & 31;
          const float inv = (float)pow(10000.0, -(double)f / 32.0); const float p = (float)(axis ? (pos & 63) : (pos >> 6)); const float ang = p * inv;
          rc[i] = (float)cos((double)ang); rs[i] = (float)sin((double)ang); } }
}
__device__ __forceinline__ const float* x_row(KA a, int row) { return row < NCTX ? a->in[I_XP] + (size_t)row * DM : a->in[I_XS] + (size_t)(row - NCTX) * DM; }
__device__ __forceinline__ int set_of(int row) { return row < NCTX ? 0 : 1 + ((row - NCTX) >> 11); }
template <int NV> __device__ __forceinline__ void fill_mod_lds(KA a, LAS float* L, int setLo, int setHi, const int (&vi)[NV], int tid) {
    const float* mod = (const float*)(a->ws + WS_MOD);
    for (int idx = tid; idx < 2 * NV * 1024; idx += NWAVES * 64) { const int bank = idx / (NV * 1024), v = (idx / 1024) % NV, c4 = idx & 1023;
        *(LAS f32x4*)(L + (size_t)((bank * NV + v) * 4096 + 4 * c4)) = *(const f32x4*)(mod + (size_t)(bank ? setHi : setLo) * 24576 + vi[v] * DM + 4 * c4); }
    __syncthreads();
}
#define LOADX(X, r) do { const float* _p = x_row(a, (r)) + 8 * lane; _Pragma("unroll") for (int j = 0; j < 8; ++j) { X[j][0] = __builtin_nontemporal_load((const f32x4*)(_p + 512 * j)); X[j][1] = __builtin_nontemporal_load((const f32x4*)(_p + 512 * j + 4)); } } while (0)
#define LOADY(Y, base, r) do { const bf16* _p = (base) + (size_t)(r) * DM + 8 * lane; _Pragma("unroll") for (int j = 0; j < 8; ++j) Y[j] = *(const u32x4*)(_p + 512 * j); } while (0)
#define LOADO(X, r) do { const float* _p = a->out + (size_t)(r) * DM + 8 * lane; _Pragma("unroll") for (int j = 0; j < 8; ++j) { X[j][0] = *(const f32x4*)(_p + 512 * j); X[j][1] = *(const f32x4*)(_p + 512 * j + 4); } } while (0)
__device__ __forceinline__ float ssq_x(const f32x4 (&x)[8][2]) { float ss = 0.f;
#pragma unroll
    for (int j = 0; j < 8; ++j)
#pragma unroll
        for (int h = 0; h < 2; ++h) ss += (x[j][h][0] * x[j][h][0] + x[j][h][1] * x[j][h][1]) + (x[j][h][2] * x[j][h][2] + x[j][h][3] * x[j][h][3]);
    return ss; }
__device__ __forceinline__ float ssq_y(const u32x4 (&yp)[8]) { float ss = 0.f;
#pragma unroll
    for (int j = 0; j < 8; ++j) { float y[8]; unpack8(yp[j], y);
#pragma unroll
        for (int e = 0; e < 8; ++e) ss += y[e] * y[e]; }
    return ss; }
__device__ __forceinline__ void p1_row(KA a, f32x4 (&x)[8][2], int row, const LAS float* L, int setLo, int lane) {
    const float rstd = rsqrtf(wave_sum(ssq_x(x)) * (1.f / DM) + EPS);
    const LAS float* Lb = L + (set_of(row) == setLo ? 0 : 2 * 4096) + 8 * lane; bf16* hrow = (bf16*)(a->ws + WS_H) + (size_t)row * DM + 8 * lane;
    float amax = 0.f;
#pragma unroll
    for (int j = 0; j < 8; ++j) {
#pragma unroll
        for (int h = 0; h < 2; ++h) { const int c = 512 * j + 4 * h; x[j][h] = (x[j][h] * rstd) * *(const LAS f32x4*)(Lb + c) + *(const LAS f32x4*)(Lb + 4096 + c);
            const f32x4 ab = __builtin_elementwise_abs(x[j][h]); amax = fmaxf(amax, fmaxf(fmaxf(ab[0], ab[1]), fmaxf(ab[2], ab[3]))); }
        *(u32x4*)(hrow + 512 * j) = pg8::pack8(x[j][0], x[j][1]); }
#pragma unroll
    for (int o = 1; o < 64; o <<= 1) amax = fmaxf(amax, __shfl_xor(amax, o));
    const float sa = amax > 0.f ? amax * (1.f / 127.f) : 1.f, inv = 1.f / sa;
    if (lane == 0) ((float*)(a->ws + WS_SA))[row] = sa;
    signed char* qrow = (signed char*)(a->ws + WS_H8) + (size_t)row * DM + 8 * lane;
#pragma unroll
    for (int j = 0; j < 8; ++j) { unsigned w[2];
#pragma unroll
        for (int h = 0; h < 2; ++h) { const f32x4 q = x[j][h] * inv;
            const int q0 = (int)rintf(q[0]), q1 = (int)rintf(q[1]), q2 = (int)rintf(q[2]), q3 = (int)rintf(q[3]);
            w[h] = (unsigned)(q0 & 255) | ((unsigned)(q1 & 255) << 8) | ((unsigned)(q2 & 255) << 16) | ((unsigned)(q3 & 255) << 24); }
        u32x2 pw; pw.x = w[0]; pw.y = w[1]; *(u32x2*)(qrow + 512 * j) = pw; }
}
template <int WHICH> __device__ __forceinline__ void p1_w8(KA a, int vcu, int G, int wave, int lane, int tid, LAS unsigned char* T) {
    constexpr int NBN = WHICH == 0 ? 48 : WHICH == 1 ? 43 : 16, N = WHICH == 0 ? INW : WHICH == 1 ? UPW : DM;
    const float* W = a->in[WHICH == 0 ? I_WIN : WHICH == 1 ? I_WUP : I_WAO]; const unsigned* cmax = (const unsigned*)(a->ws + WS_CTL) + (WHICH == 0 ? CW_CMAX : WHICH == 1 ? CW_CMAX2 : CW_CMAX3);
    signed char* W8 = (signed char*)(a->ws + (WHICH == 0 ? WS_W8 : WHICH == 1 ? WS_WUP8 : WS_WA8)); float* SB = (float*)(a->ws + (WHICH == 0 ? WS_SB : WHICH == 1 ? WS_SB2 : WS_SB3));
#define W8ROW(n_) (WHICH == 0 ? w8_row(n_) : WHICH == 1 ? (n_) - DFF : (n_))
    for (int it = vcu; it < 32 * NBN; it += G) {
        const int kb = it / NBN, nq = it % NBN, nb = WHICH == 0 ? (nq < 16 ? nq : nq + 32) : WHICH == 1 ? nq + 43 : nq;
        const int n = nb * 256 + 4 * lane;
        const float* src = W + (size_t)(kb * 128 + wave * 16) * N + n;
        f32x4 v[16];
#pragma unroll
        for (int j = 0; j < 16; ++j) v[j] = __builtin_nontemporal_load((const f32x4*)(src + (size_t)j * N));
        f32x4 inv;
#pragma unroll
        for (int i = 0; i < 4; ++i) { const float m = __uint_as_float(cmax[W8ROW(n + i)]); inv[i] = m > 0.f ? 127.f / m : 0.f; }
        __syncthreads();
#pragma unroll
        for (int i = 0; i < 4; ++i) { u32x4 w;
#pragma unroll
            for (int d = 0; d < 4; ++d) { unsigned x = 0;
#pragma unroll
                for (int e = 0; e < 4; ++e) { const int q = (int)rintf(v[4 * d + e][i] * inv[i]); x |= (unsigned)(q & 255) << (8 * e); }
                w[d] = x; }
            *(LAS u32x4*)(T + (4 * lane + i) * 144 + wave * 16) = w; }
        __syncthreads();
#pragma unroll
        for (int q = 0; q < 4; ++q) { const int idx = q * 512 + tid, row = idx >> 3, ch = idx & 7;
            const u32x4 w = *(const LAS u32x4*)(T + row * 144 + ch * 16);
            *(u32x4*)(W8 + (size_t)W8ROW(nb * 256 + row) * 4096 + kb * 128 + ch * 16) = w; }
        if (kb == 0 && tid < 256) { const float m = __uint_as_float(cmax[W8ROW(nb * 256 + tid)]); SB[W8ROW(nb * 256 + tid)] = m > 0.f ? m * (1.f / 127.f) : 1.f; }
    }
    __syncthreads();
#undef W8ROW
}
__device__ __forceinline__ void p1_h1(KA a, unsigned char* lds_g, int vcu, int G, int wave, int lane, int tid) {
    LAS float* L = (LAS float*)lds_g;
    const int nrb = (MTOT + G - 1) / G, base = vcu * nrb, lim = (base + nrb) < MTOT ? (base + nrb) : MTOT;
    if (base < MTOT) {
        const int setLo = set_of(base); { const int vi[2] = {1, 0}; fill_mod_lds<2>(a, L, setLo, set_of(lim - 1), vi, tid); }
        f32x4 xa[8][2], xb[8][2];
        int row = base + wave;
        if (row < lim) LOADX(xa, row);
        for (; row < lim; row += 2 * NWAVES) {
            const int r2 = row + NWAVES, r3 = row + 2 * NWAVES;
            if (r2 < lim) LOADX(xb, r2);
            p1_row(a, xa, row, L, setLo, lane);
            if (r3 < lim) LOADX(xa, r3);
            if (r2 < lim) p1_row(a, xb, r2, L, setLo, lane);
        }
    }
    p1_w8<0>(a, vcu, G, wave, lane, tid, (LAS unsigned char*)lds_g + 65536);
    p1_w8<1>(a, vcu, G, wave, lane, tid, (LAS unsigned char*)lds_g + 65536);
    p1_w8<2>(a, vcu, G, wave, lane, tid, (LAS unsigned char*)lds_g + 65536);
}
__device__ __forceinline__ void p6_row(KA a, const u32x4 (&yp)[8], f32x4 (&x)[8][2], int row, const LAS float* L, int setLo, int lane) {
    const float rstd = rsqrtf(wave_sum(ssq_y(yp)) * (1.f / DM) + EPS);
    const LAS float* Lb = L + (set_of(row) == setLo ? 0 : 3 * 4096) + 8 * lane; float* orow = a->out + (size_t)row * DM + 8 * lane; bf16* hrow = (bf16*)(a->ws + WS_H) + (size_t)row * DM + 8 * lane;
    float ss1 = 0.f;
#pragma unroll
    for (int j = 0; j < 8; ++j) { float y[8]; unpack8(yp[j], y);
#pragma unroll
        for (int h = 0; h < 2; ++h) { const int c = 512 * j + 4 * h; const f32x4 yv = (f32x4){y[4 * h], y[4 * h + 1], y[4 * h + 2], y[4 * h + 3]};
            const f32x4 x1 = x[j][h] + *(const LAS f32x4*)(Lb + c) * (yv * rstd);
            *(f32x4*)(orow + c) = x1; x[j][h] = x1; ss1 += (x1[0] * x1[0] + x1[1] * x1[1]) + (x1[2] * x1[2] + x1[3] * x1[3]); }
        asm volatile("" ::: "memory"); }
    const float rstd1 = rsqrtf(wave_sum(ss1) * (1.f / DM) + EPS);
    float amax = 0.f;
#pragma unroll
    for (int j = 0; j < 8; ++j) {
#pragma unroll
        for (int h = 0; h < 2; ++h) { const int c = 512 * j + 4 * h; x[j][h] = (x[j][h] * rstd1) * *(const LAS f32x4*)(Lb + 4096 + c) + *(const LAS f32x4*)(Lb + 2 * 4096 + c);
            const f32x4 ab = __builtin_elementwise_abs(x[j][h]); amax = fmaxf(amax, fmaxf(fmaxf(ab[0], ab[1]), fmaxf(ab[2], ab[3]))); }
        *(u32x4*)(hrow + 512 * j) = pg8::pack8(x[j][0], x[j][1]); asm volatile("" ::: "memory"); }
#pragma unroll
    for (int o = 1; o < 64; o <<= 1) amax = fmaxf(amax, __shfl_xor(amax, o));
    const float sa = amax > 0.f ? amax * (1.f / 127.f) : 1.f, inv = 1.f / sa;
    if (lane == 0) ((float*)(a->ws + WS_SA))[row] = sa;
    signed char* qrow = (signed char*)(a->ws + WS_H8) + (size_t)row * DM + 8 * lane;
#pragma unroll
    for (int j = 0; j < 8; ++j) { unsigned w[2];
#pragma unroll
        for (int h = 0; h < 2; ++h) { const f32x4 q = x[j][h] * inv;
            const int q0 = (int)rintf(q[0]), q1 = (int)rintf(q[1]), q2 = (int)rintf(q[2]), q3 = (int)rintf(q[3]);
            w[h] = (unsigned)(q0 & 255) | ((unsigned)(q1 & 255) << 8) | ((unsigned)(q2 & 255) << 16) | ((unsigned)(q3 & 255) << 24); }
        u32x2 pw; pw.x = w[0]; pw.y = w[1]; *(u32x2*)(qrow + 512 * j) = pw; }
}
__device__ __forceinline__ void p6_x1_h2(KA a, unsigned char* lds_g, int vcu, int G, int wave, int lane, int tid) {
    LAS float* L = (LAS float*)lds_g; const bf16* Y = (const bf16*)(a->ws + WS_PROJ);
    const int nrb = (MTOT + G - 1) / G, base = vcu * nrb, lim = (base + nrb) < MTOT ? (base + nrb) : MTOT;
    if (base >= MTOT) return;
    const int setLo = set_of(base); { const int vi[3] = {2, 4, 3}; fill_mod_lds<3>(a, L, setLo, set_of(lim - 1), vi, tid); }
    u32x4 ya[8], yb[8]; f32x4 xa[8][2], xb[8][2];
    const int lane0 = lane;
    for (int row = base + wave; row < lim; row += 2 * NWAVES) {
        const int r2 = row + NWAVES;
        int lane = lane0; asm volatile("" : "+v"(lane));
        LOADY(ya, Y, row); LOADX(xa, row);
        if (r2 < lim) { LOADY(yb, Y, r2); LOADX(xb, r2); }
        p6_row(a, ya, xa, row, L, setLo, lane);
        if (r2 < lim) p6_row(a, yb, xb, r2, L, setLo, lane);
    }
}
#undef LOADX
#undef LOADY
#undef LOADO
constexpr int NR = 2;
__device__ __forceinline__ const float* mod_row(KA a, int row) { return (const float*)(a->ws + WS_MOD) + (size_t)set_of(row) * 24576; }
__device__ __forceinline__ void p10_final(KA a, int gw, int NGW, int lane, const bool dry) {
    const bf16* Fb = (const bf16*)(a->ws + WS_H);
    for (int row0 = gw; row0 < MTOT; row0 += NR * NGW) {
        int row[NR]; bool ok[NR]; u32x4 yp[NR][8]; f32x4 x[NR][8][2]; float rstd[NR];
#pragma unroll
        for (int i = 0; i < NR; ++i) { const int r = row0 + i * NGW; ok[i] = r < MTOT; row[i] = ok[i] ? r : row0;
            const bf16* frow = Fb + (size_t)row[i] * DM + 8 * lane; const float* orow = a->out + (size_t)row[i] * DM + 8 * lane;
#pragma unroll
            for (int j = 0; j < 8; ++j) yp[i][j] = *(const u32x4*)(frow + 512 * j);
#pragma unroll
            for (int j = 0; j < 8; ++j) { x[i][j][0] = *(const f32x4*)(orow + 512 * j); x[i][j][1] = *(const f32x4*)(orow + 512 * j + 4); } }
#pragma unroll
        for (int i = 0; i < NR; ++i) { float ss = 0.f;
#pragma unroll
            for (int j = 0; j < 8; ++j) { float y[8]; unpack8(yp[i][j], y);
#pragma unroll
                for (int e = 0; e < 8; ++e) ss += y[e] * y[e]; }
            rstd[i] = rsqrtf(wave_sum(ss) * (1.f / DM) + EPS); }
#pragma unroll
        for (int i = 0; i < NR; ++i) { const float* md = mod_row(a, row[i]) + 5 * DM + 8 * lane;
            float* orow = (dry ? (float*)(a->ws + WS_F) : a->out) + (size_t)row[i] * DM + 8 * lane;
#pragma unroll
            for (int j = 0; j < 8; ++j) { float y[8]; unpack8(yp[i][j], y);
#pragma unroll
                for (int h = 0; h < 2; ++h) { const int c = 512 * j + 4 * h; const f32x4 m5 = *(const f32x4*)(md + c);
                    const f32x4 yv = (f32x4){y[4 * h], y[4 * h + 1], y[4 * h + 2], y[4 * h + 3]};
                    if (ok[i]) *(f32x4*)(orow + c) = x[i][j][h] + m5 * (yv * rstd[i]); } }
        }
    }
}
__device__ __forceinline__ void p3_sconv(KA a, int gw, int NGW, int lane, const bool dry) {
    bf16* P = (bf16*)(a->ws + WS_PROJ); const float* w = a->in[I_WSCONV];
    for (int it = gw; it < (MTOT / 8) * 4; it += NGW) {
        const int r0 = (it >> 2) * 8, ch0 = (it & 3) * 512 + 8 * lane;
        const int L = r0 < NCTX ? 256 : 2048, t0 = r0 < NCTX ? (r0 & 255) : ((r0 - NCTX) & 2047);
        bf16* base = P + (size_t)r0 * INW + ch0;
        u32x4 cc[10], ch[10], cb[8];
        const u32x4 z = (u32x4){0u, 0u, 0u, 0u};
        if (t0 > 0) { cc[0] = *(const u32x4*)(base - INW + C_CC); ch[0] = *(const u32x4*)(base - INW + C_CH); } else { cc[0] = z; ch[0] = z; }
#pragma unroll
        for (int i = 0; i < 8; ++i) { cc[i + 1] = *(const u32x4*)(base + (size_t)i * INW + C_CC); ch[i + 1] = *(const u32x4*)(base + (size_t)i * INW + C_CH); cb[i] = *(const u32x4*)(base + (size_t)i * INW + C_CB); }
        if (t0 + 8 < L) { cc[9] = *(const u32x4*)(base + (size_t)8 * INW + C_CC); ch[9] = *(const u32x4*)(base + (size_t)8 * INW + C_CH); } else { cc[9] = z; ch[9] = z; }
        float w0[8], w1[8], w2[8];
#pragma unroll
        for (int e = 0; e < 8; ++e) { w0[e] = w[ch0 + e]; w1[e] = w[CONVD + ch0 + e]; w2[e] = w[2 * CONVD + ch0 + e]; }
        float prev[8], cur[8], nxt[8], t1[8], t2[8];
        unpack8(cc[0], t1); unpack8(ch[0], t2);
#pragma unroll
        for (int e = 0; e < 8; ++e) prev[e] = t1[e] * t2[e];
        unpack8(cc[1], t1); unpack8(ch[1], t2);
#pragma unroll
        for (int e = 0; e < 8; ++e) cur[e] = t1[e] * t2[e];
#pragma unroll
        for (int i = 0; i < 8; ++i) {
            unpack8(cc[i + 2], t1); unpack8(ch[i + 2], t2);
#pragma unroll
            for (int e = 0; e < 8; ++e) nxt[e] = t1[e] * t2[e];
            float cbf[8], o[8]; unpack8(cb[i], cbf);
#pragma unroll
            for (int e = 0; e < 8; ++e) { o[e] = cbf[e] * (w0[e] * prev[e] + w1[e] * cur[e] + w2[e] * nxt[e]); prev[e] = cur[e]; cur[e] = nxt[e]; }
            if (dry) *(u32x4*)((bf16*)(a->ws + WS_H) + (size_t)(r0 + i) * DM + ch0) = pack8f(o); else *(u32x4*)(base + (size_t)i * INW + C_CB) = pack8f(o);
        }
    }
}
__device__ __forceinline__ void p4_quant_a(KA a, int gw, int NGW, int lane) {
    const bf16* P = (const bf16*)(a->ws + WS_PROJ); signed char* A8 = (signed char*)(a->ws + WS_H8); float* SA = (float*)(a->ws + WS_SA);
    for (int row0 = gw; row0 < MTOT; row0 += 2 * NGW) {
        u32x4 v[2][8]; int row[2]; bool ok[2];
#pragma unroll
        for (int i = 0; i < 2; ++i) { const int r = row0 + i * NGW; ok[i] = r < MTOT; row[i] = ok[i] ? r : row0; const bf16* p = P + (size_t)row[i] * INW + C_Q + 8 * lane;
#pragma unroll
            for (int j = 0; j < 8; ++j) v[i][j] = *(const u32x4*)(p + 512 * j); }
#pragma unroll
        for (int i = 0; i < 2; ++i) { float amax = 0.f;
#pragma unroll
            for (int j = 0; j < 8; ++j) { float f[8]; unpack8(v[i][j], f);
#pragma unroll
                for (int e = 0; e < 8; ++e) amax = fmaxf(amax, fabsf(f[e])); }
#pragma unroll
            for (int o = 1; o < 64; o <<= 1) amax = fmaxf(amax, __shfl_xor(amax, o));
            const float sa = amax > 0.f ? amax * (1.f / 127.f) : 1.f, inv = 1.f / sa;
            if (ok[i]) { if (lane == 0) SA[row[i]] = sa;
#pragma unroll
                for (int j = 0; j < 8; ++j) { float f[8]; unpack8(v[i][j], f); unsigned w[2];
#pragma unroll
                    for (int h = 0; h < 2; ++h) { const int q0 = (int)rintf(f[4 * h] * inv), q1 = (int)rintf(f[4 * h + 1] * inv), q2 = (int)rintf(f[4 * h + 2] * inv), q3 = (int)rintf(f[4 * h + 3] * inv);
                        w[h] = (unsigned)(q0 & 255) | ((unsigned)(q1 & 255) << 8) | ((unsigned)(q2 & 255) << 16) | ((unsigned)(q3 & 255) << 24); }
                    u32x2 pw; pw.x = w[0]; pw.y = w[1]; *(u32x2*)(A8 + (size_t)row[i] * DM + 512 * j + 8 * lane) = pw; } }
        }
    }
}
__device__ __forceinline__ void p8_fixup(KA a, int gtid, int NGT) {
    bf16* Fb = (bf16*)(a->ws + WS_F); const float* w = a->in[I_WFCONV]; const float* sbg = (const float*)(a->ws + WS_SBG); const bf16* VAL = (const bf16*)(a->ws + WS_VAL);
    constexpr int NC4 = DFF / 4;
    for (int i = gtid; i < 56 * NC4; i += NGT) {
        const int sidx = i / NC4, c = (i % NC4) * 4; const int T = 32 + (sidx / 7) * 8 + (sidx % 7);
        const f32x4 gA254 = *(const f32x4*)(sbg + ((size_t)T * 4 + 2) * DFF + c), gA255 = *(const f32x4*)(sbg + ((size_t)T * 4 + 3) * DFF + c);
        const f32x4 gB0 = *(const f32x4*)(sbg + ((size_t)(T + 1) * 4 + 0) * DFF + c), gB1 = *(const f32x4*)(sbg + ((size_t)(T + 1) * 4 + 1) * DFF + c);
        const u32x2 pA = *(const u32x2*)(VAL + ((size_t)T * 256 + 255) * DFF + c), pB = *(const u32x2*)(VAL + ((size_t)(T + 1) * 256) * DFF + c);
        const f32x4 vA = (f32x4){pg8::bf_lo(pA.x), pg8::bf_hi(pA.x), pg8::bf_lo(pA.y), pg8::bf_hi(pA.y)}, vB = (f32x4){pg8::bf_lo(pB.x), pg8::bf_hi(pB.x), pg8::bf_lo(pB.y), pg8::bf_hi(pB.y)};
        const f32x4 w0 = *(const f32x4*)(w + c), w1 = *(const f32x4*)(w + DFF + c), w2 = *(const f32x4*)(w + 2 * DFF + c);
        const f32x4 ca = w0 * gA254 + w1 * gA255 + w2 * gB0, cb = w0 * gA255 + w1 * gB0 + w2 * gB1;
        f32x4 oa, ob;
#pragma unroll
        for (int j = 0; j < 4; ++j) { oa[j] = ca[j] * __builtin_amdgcn_rcpf(1.f + __expf(-ca[j])) * vA[j]; ob[j] = cb[j] * __builtin_amdgcn_rcpf(1.f + __expf(-cb[j])) * vB[j]; }
        u32x2 pa, pb; pa.x = pk2(oa[0], oa[1]); pa.y = pk2(oa[2], oa[3]); pb.x = pk2(ob[0], ob[1]); pb.y = pk2(ob[2], ob[3]);
        *(u32x2*)(Fb + ((size_t)T * 256 + 255) * DFF + c) = pa; *(u32x2*)(Fb + ((size_t)(T + 1) * 256) * DFF + c) = pb;
    }
}
__device__ __forceinline__ void p3_attention(KA a, char* lds, int vcu, int G, int tid, const bool dry) {
    bf16* P = (bf16*)(a->ws + WS_PROJ); const bf16* CKb = (const bf16*)(a->ws + WS_CK); const bf16* CVb = (const bf16*)(a->ws + WS_CV); const float* sinkp = a->in[I_SINK];
    const int wid = tid >> 6, lane = tid & 63, r32 = lane & 31, hi = lane >> 5;
    const int perL = (2048 + G - 1) / G, perC = (1024 + G - 1) / G;
    for (int i = 0; i < perL + perC; ++i) {
        const bool lat = i < perL;
        const int id = lat ? vcu * perL + i : vcu * perC + (i - perL);
        if (id >= (lat ? 2048 : 1024)) continue;
        att::Src S; int rowbase, kvh, hp, qb;
        if (lat) { hp = id & 1; qb = (id >> 1) & 15; kvh = (id >> 5) & 7; const int b = id >> 8; rowbase = NCTX + b * 2048;
            const int kb_lo = qb > 0 ? qb - 1 : 0, kb_hi = qb < 15 ? qb + 1 : 15;
            S.nA = 8; S.KA = CKb + (size_t)b * PAST * KVW + kvh * 128; S.VA = CVb + (size_t)b * PAST * KVW + kvh * 128;
            S.nB = (kb_hi - kb_lo + 1) * 2; S.kpos0 = kb_lo * 128; S.masked = 1; }
        else { hp = id & 1; qb = (id >> 1) & 1; kvh = (id >> 2) & 7; const int b = id >> 5; rowbase = b * 256;
            S.nA = 0; S.KA = CKb; S.VA = CVb; S.nB = 4; S.kpos0 = 0; S.masked = 0; }
        S.qpos0 = qb * 128;
        S.KB = P + (size_t)(rowbase + S.kpos0) * INW + C_K + kvh * 128; S.VB = P + (size_t)(rowbase + S.kpos0) * INW + C_V + kvh * 128;
        const int head = kvh * 4 + hp * 2 + (wid >> 2);
        const size_t qrow0 = (size_t)rowbase + qb * 128 + 32 * (wid & 3);
        bf16* Ow = dry ? (bf16*)(a->ws + WS_H) + qrow0 * DM + head * 128 : P + qrow0 * INW + C_Q + head * 128;
        att::attn_unit(P + (qrow0 + r32) * INW + C_Q + head * 128 + hi * 8, Ow, S, sinkp[head], lds, tid, dry ? DM : INW);
    }
}

__global__ void __launch_bounds__(NWAVES * 64, 2) mk_fwd(Args args_) {
    const KA kp = (KA)__builtin_amdgcn_kernarg_segment_ptr(); (void)args_;
#define args (launder(kp))
    extern __shared__ __attribute__((aligned(16))) unsigned char lds[];
    const int wave = __builtin_amdgcn_readfirstlane((int)threadIdx.x >> 6);
#define LANE_TID() const int lane = lane_id(); const int tid = wave * 64 + lane; (void)tid; (void)lane
    const int G = gridDim.x; const int bx = blockIdx.x; const int vcu = (G % 8 == 0) ? (bx % 8) * (G / 8) + bx / 8 : bx;
    const int gw = vcu * NWAVES + wave, NGW = G * NWAVES;
    LAS unsigned char* ldsl = (LAS unsigned char*)lds;
    volatile LAS unsigned* MISC = (volatile LAS unsigned*)(ldsl + MISC_OFF);
    { LANE_TID(); for (int u = tid; u < (LDS_BYTES - RING_BYTES) / 4; u += NWAVES * 64) ((LAS unsigned*)(ldsl + RING_BYTES))[u] = 0u; }
    __syncthreads();
    unsigned* ctl = (unsigned*)(args->ws + WS_CTL);
    XcdBarrier bar; bar.bar = ctl + CW_BAR; bar.x = 0; bar.st = nullptr;
    if (N_LAUNCHES == 1) { LANE_TID(); bar = xcd_barrier_post(ctl + CW_BAR, MISC + 8, tid); }
    const int lo = args->ph_lo, hi = args->ph_hi;
#ifndef PHASE_MASK
#define PHASE_MASK 0x7ff
#endif
#define IN(k) ((((PHASE_MASK) >> (k)) & 1) && lo <= (k) && (k) < hi)
#ifndef REPEAT_MASK
#define REPEAT_MASK 0
#endif
#ifndef PROBE_P0
#define PROBE_P0 0
#endif
#ifndef PROBE_DRY
#define PROBE_DRY 0
#endif
#define REPS(k) (1 + ((((REPEAT_MASK) | (PROBE_DRY)) >> (k)) & 1))
#define SEAM(k) do { if (IN(k) && IN((k) + 1)) { LANE_TID(); xcd_barrier(bar, tid); } } while (0)
#define Hb ((bf16*)(args->ws + WS_H))
#define Pb ((bf16*)(args->ws + WS_PROJ))
#define Fb ((bf16*)(args->ws + WS_F))

    if (IN(0)) for (int rep_ = 0; rep_ < REPS(0); ++rep_) { LANE_TID();
        for (int r2 = 0; r2 < 1 + (PROBE_P0 & 1); ++r2) p0_mod(args, lds, tid, G);
        for (int r2 = 0; r2 < 1 + (PROBE_P0 >> 1 & 1); ++r2) p0_convert(args, vcu, G, wave, lane, tid, gw * 64 + lane, NGW * 64, ldsl); }
    SEAM(0);
    if (IN(1)) for (int rep_ = 0; rep_ < REPS(1); ++rep_) { LANE_TID(); p1_h1(args, lds, vcu, G, wave, lane, tid); }
    SEAM(1);
    if (IN(2)) for (int rep_ = 0; rep_ < REPS(2); ++rep_) {
        LANE_TID();
        { pg8::Gemm g{Hb, (const bf16*)(args->ws + WS_WIN), MTOT, 8192, DM, DM, 1 << 30, 0}; pg8::GroupOrder S; S.init(MTOT, 8192, G, vcu); S.off0 = 16;
          pg8::EpiIn E{Pb, args->out + O_NK, args->out + O_NV, (const float*)(args->ws + WS_ROPE), (const float*)(args->ws + WS_ROPE) + 2048 * 64};
          pg8::gemm_phase<pg8::EpiIn, pg8::GroupOrder, true>(ldsl, g, S, E, tid); }
        { pg8::Gemm g{(const bf16*)(args->ws + WS_H8), (const bf16*)(args->ws + WS_W8), MTOT, 12288, DM, DM, 1 << 30, 0}; pg8::GroupOrder S; S.init(MTOT, 12288, G, vcu); S.split = 16; S.off0 = 0; S.off1 = 32;
          pg8::EpiIn8 E{Pb, (const float*)(args->ws + WS_SA), (const float*)(args->ws + WS_SB), (const float*)(args->ws + WS_ROPE), (const float*)(args->ws + WS_ROPE) + 2048 * 64};
          pg8::gemm_phase<pg8::EpiIn8, pg8::GroupOrder, true, true>(ldsl, g, S, E, tid); }
    }
    SEAM(2);
    if (IN(3)) for (int rep_ = 0; rep_ < REPS(3); ++rep_) { LANE_TID(); const bool dry = (PROBE_DRY >> 3 & 1) && rep_ == 0; p3_attention(args, (char*)lds, vcu, G, tid, dry); p3_sconv(args, gw, NGW, lane, dry); }
    SEAM(3);
    if (IN(4)) for (int rep_ = 0; rep_ < REPS(4); ++rep_) {
        LANE_TID();
        p4_quant_a(args, gw, NGW, lane);
        if (lo < hi - 1 || N_LAUNCHES == 1) xcd_barrier(bar, tid);
        { pg8::Gemm g{(const bf16*)(args->ws + WS_H8), (const bf16*)(args->ws + WS_WA8), MTOT, DM, DM, DM, 1 << 30, 0}; pg8::GroupOrder S; S.init(MTOT, DM, G, vcu);
          pg8::EpiT1 E{Pb, Hb, (const float*)(args->ws + WS_SA), (const float*)(args->ws + WS_SB3)};
          pg8::gemm_phase<pg8::EpiT1, pg8::GroupOrder, true, true>(ldsl, g, S, E, tid); }
        { pg8::Gemm g{Pb + C_CB, (const bf16*)(args->ws + WS_WCAT), MTOT, DM, CONVD, INW, 1 << 30, 0}; pg8::GroupOrder S; S.init(MTOT, DM, G, vcu);
          pg8::EpiMerge2 E{Pb, Hb};
          pg8::gemm_phase<pg8::EpiMerge2, pg8::GroupOrder, true>(ldsl, g, S, E, tid); }
    }
    SEAM(4);
    if (IN(5)) for (int rep_ = 0; rep_ < REPS(5); ++rep_) {
        pg8::Gemm g{Hb, (const bf16*)(args->ws + WS_WMIX), MTOT, DM, DM, DM, 1 << 30, 0}; LANE_TID(); pg8::GroupOrder S; S.init(MTOT, DM, G, vcu);
        pg8::EpiStore E{Pb, DM};
        pg8::gemm_phase<pg8::EpiStore, pg8::GroupOrder, true>(ldsl, g, S, E, tid);
    }
    SEAM(5);
    if (IN(6)) for (int rep_ = 0; rep_ < REPS(6); ++rep_) { LANE_TID(); p6_x1_h2(args, lds, vcu, G, wave, lane, tid); }
    SEAM(6);
    if (IN(7)) for (int rep_ = 0; rep_ < REPS(7); ++rep_) {
        LANE_TID();
        { pg8::Gemm g{(const bf16*)(args->ws + WS_H8), (const bf16*)(args->ws + WS_WUP8), MTOT, DFF, DM, DM, 1 << 30, 0}; pg8::GroupOrder S; S.init(MTOT, DFF, G, vcu);
          pg8::EpiVal E{(bf16*)(args->ws + WS_VAL), (const float*)(args->ws + WS_SA), (const float*)(args->ws + WS_SB2)};
          pg8::gemm_phase<pg8::EpiVal, pg8::GroupOrder, true, true>(ldsl, g, S, E, tid); }
        if (lo < hi - 1 || N_LAUNCHES == 1) xcd_barrier(bar, tid);
        { pg8::Gemm g{Hb, (const bf16*)(args->ws + WS_WUP), MTOT, DFF, DM, DM, 1 << 30, 0}; pg8::GroupOrder S; S.init(MTOT, DFF, G, vcu);
          pg8::EpiUp E{Fb, (const bf16*)(args->ws + WS_VAL), args->in[I_WFCONV], (float*)(args->ws + WS_SBG), (LAS float*)(ldsl + RING_BYTES + 1024)};
          pg8::gemm_phase<pg8::EpiUp, pg8::GroupOrder, true>(ldsl, g, S, E, tid); }
    }
    SEAM(7);
    if (IN(8)) for (int rep_ = 0; rep_ < REPS(8); ++rep_) { LANE_TID(); p8_fixup(args, gw * 64 + lane, NGW * 64); }
    SEAM(8);
    if (IN(9)) for (int rep_ = 0; rep_ < REPS(9); ++rep_) {
        pg8::Gemm g{Fb, (const bf16*)(args->ws + WS_WDN), MTOT, DM, DFF, DFF, 1 << 30, 0}; LANE_TID(); pg8::GroupOrder S; S.init(MTOT, DM, G, vcu);
        pg8::EpiStore E{Hb, DM};
        pg8::gemm_phase<pg8::EpiStore, pg8::GroupOrder, true>(ldsl, g, S, E, tid);
    }
    SEAM(9);
    if (IN(10)) for (int rep_ = 0; rep_ < REPS(10); ++rep_) { LANE_TID(); const bool dry = (PROBE_DRY >> 10 & 1) && rep_ == 0; p10_final(args, gw, NGW, lane, dry); }
#undef IN
#undef SEAM
#undef Hb
#undef Pb
#undef Fb
#undef args
}

extern "C" void kernel_launch(void* const* d_in, const int* in_sizes, int n_in, void* d_out, int out_size, void* d_ws, size_t ws_size, hipStream_t stream) {
    static int grid = 0;
    if (grid == 0) {
        if (n_in != 21 || (size_t)out_size != O_END || ws_size < WS_END) { fprintf(stderr, "kernel_launch: shape mismatch (n_in %d out %d ws %zu; need ws >= %zu)\n", n_in, out_size, ws_size, (size_t)WS_END); grid = -1; return; }
        int dev = 0, cus = 0;
        if (hipGetDevice(&dev) != hipSuccess || hipDeviceGetAttribute(&cus, hipDeviceAttributeMultiprocessorCount, dev) != hipSuccess) { grid = -1; return; }
        if (hipFuncSetAttribute((const void*)mk_fwd, hipFuncAttributeMaxDynamicSharedMemorySize, LDS_BYTES) != hipSuccess) { fprintf(stderr, "kernel_launch: hipFuncSetAttribute failed\n"); grid = -1; return; }
        int per_cu = 0;
        if (hipOccupancyMaxActiveBlocksPerMultiprocessor(&per_cu, (const void*)mk_fwd, NWAVES * 64, LDS_BYTES) != hipSuccess || per_cu < 1) fprintf(stderr, "kernel_launch: occupancy query reports %d\n", per_cu);
        (void)hipGetLastError();
        grid = cus;
    }
    if (grid < 0) return;
    (void)hipMemsetAsync((char*)d_ws + WS_CTL, 0, CTL_ZERO_BYTES, stream);
    Args a{};
    for (int i = 0; i < 21; ++i) a.in[i] = (const float*)d_in[i];
    a.out = (float*)d_out; a.ws = (unsigned char*)d_ws;
    for (int li = 0; li < N_LAUNCHES; ++li) {
        a.ph_lo = (N_LAUNCHES == 1) ? 0 : li; a.ph_hi = (N_LAUNCHES == 1) ? N_PHASES : li + 1;
        hipLaunchKernelGGL(mk_fwd, dim3(grid), dim3(NWAVES * 64), LDS_BYTES, stream, a);
    }
}
```

```cpp
#include <hip/hip_runtime.h>
#include <cstdio>
#include <cstdint>

constexpr int DM = 4096, NCTX = 8192, NLAT = 16384, MTOT = 24576;
constexpr int INW = 20480, DFF = 11008, UPW = 22016, KVW = 1024, CONVD = 2048, PAST = 512;
constexpr int C_Q = 0, C_K = 4096, C_V = 5120, C_CB = 6144, C_CC = 8192, C_CH = 10240, C_GA = 12288, C_GC = 16384;
constexpr float EPS = 1e-6f;

namespace pg8 {
#define PG8_LAS __attribute__((address_space(3)))
typedef unsigned short bf16_t;
typedef short bf16x8 __attribute__((ext_vector_type(8)));
typedef float f32x4 __attribute__((ext_vector_type(4)));
typedef unsigned u32x4 __attribute__((ext_vector_type(4)));
typedef int i32x4 __attribute__((ext_vector_type(4)));
constexpr int BM = 256, BK = 64, HALF = 128, HTB = HALF * BK * 2  , STAGE_BYTES = 8 * HTB, NXCD = 8, WGM = 8;

__host__ __device__ __forceinline__ int lds_byte(int r, int c) { const int st = (r >> 4) * 2 + (c >> 5), rr = r & 15, cc = c & 31, ob = rr * 64 + cc * 2; return st * 1024 + (ob ^ (((ob >> 9) & 1) << 5)); }
__host__ __device__ __forceinline__ void stage_rc(int b, int& R, int& C) { const int st = b / 1024, sb = b % 1024, swz = sb ^ (((sb >> 9) & 1) << 5); R = (st >> 1) * 16 + swz / 64; C = (st & 1) * 32 + (swz % 64) / 2; }
__host__ __device__ __forceinline__ int perm32(int rho) { const int n = rho >> 4, i = rho & 15; return 8 * (i >> 2) + 4 * n + (i & 3); }

struct Unit { int pm, pn, pnb; };
struct Gemm { const bf16_t* A; const bf16_t* Bt; int M, N, K, lda, kj_t, kj_bytes; };

struct StaticOrder {
    int nM, nN, nwg, G, c;
    __host__ __device__ void init(int M, int N, int G_, int c_) { nM = M / BM; nN = N / BM; nwg = nM * nN; G = G_; c = c_; }
    __host__ __device__ bool next(int i, Unit& u) const {
        const long L = (long)i * G + c; if (L >= nwg) return false;
        int wgid = (int)L; { const int q = nwg / NXCD, r = nwg % NXCD, xcd = wgid % NXCD, off = wgid / NXCD; wgid = (xcd < r ? xcd * (q + 1) : r * (q + 1) + (xcd - r) * q) + off; }
        const int nig = WGM * nN, gid = wgid / nig, fm = gid * WGM, gsz = (nM - fm) < WGM ? (nM - fm) : WGM;
        u.pm = fm + ((wgid % nig) % gsz); u.pn = (wgid % nig) / gsz; u.pnb = u.pn; return true;
    }
    __device__ __forceinline__ void a_ready(const Unit&) const {}
    __device__ __forceinline__ void done(const Unit&) const {}
};
struct GroupOrder {
    int nM, nN, nwg, G, c, split = 1 << 30, off0 = 0, off1 = 0;
    __host__ __device__ void init(int M, int N, int G_, int c_) { nM = M / BM; nN = N / BM; nwg = nM * nN; G = G_; c = c_; }
    __host__ __device__ bool next(int i, Unit& u) const {
        const long L = (long)i * G + c; if (L >= nwg) return false;
        const int w = (int)L, nig = WGM * nN, gid = w / nig, fm = gid * WGM, gsz = (nM - fm) < WGM ? (nM - fm) : WGM;
        u.pm = fm + ((w % nig) % gsz); u.pnb = (w % nig) / gsz; u.pn = u.pnb + (u.pnb < split ? off0 : off1); return true;
    }
    __device__ __forceinline__ void a_ready(const Unit&) const {}
    __device__ __forceinline__ void done(const Unit&) const {}
};

__device__ __forceinline__ unsigned cvt_pk_bf16(float lo, float hi) { unsigned r; asm volatile("v_cvt_pk_bf16_f32 %0, %1, %2" : "=v"(r) : "v"(lo), "v"(hi)); return r; }
__device__ __forceinline__ float bf_lo(unsigned w) { return __uint_as_float(w << 16); }
__device__ __forceinline__ float bf_hi(unsigned w) { return __uint_as_float(w & 0xffff0000u); }
__device__ __forceinline__ u32x4 pack8(const f32x4 v0, const f32x4 v1) { u32x4 w; w.x = cvt_pk_bf16(v0[0], v0[1]); w.y = cvt_pk_bf16(v0[2], v0[3]); w.z = cvt_pk_bf16(v1[0], v1[1]); w.w = cvt_pk_bf16(v1[2], v1[3]); return w; }

struct EpiStore {
    typedef f32x4 acc_t;
    static constexpr bool PERM = true, HAS_MID = false;
    bf16_t* O; int ldc;
    __device__ __forceinline__ void mid(f32x4 (&)[2][2][4][2], const Unit&, int, int, int, int) const {}
    __device__ __forceinline__ void operator()(const f32x4 (&acc)[2][2][4][2], const Unit& u, int wr, int wc, int fr_, int fq_) const {
        int fr = fr_, fq = fq_; asm volatile("" : "+v"(fr), "+v"(fq));
        const int row0 = u.pm * BM + wr * 64 + fr, col0 = u.pn * BM + wc * 32 + 8 * fq;
#pragma unroll
        for (int ai = 0; ai < 2; ++ai)
#pragma unroll
            for (int m = 0; m < 4; ++m) { bf16_t* rowp = O + (size_t)(row0 + ai * HALF + m * 16) * ldc + col0;
#pragma unroll
                for (int bj = 0; bj < 2; ++bj) *(u32x4*)(rowp + bj * HALF) = pack8(acc[ai][bj][m][0], acc[ai][bj][m][1]); }
    }
};

struct EpiIn {
    typedef f32x4 acc_t;
    static constexpr bool PERM = true, HAS_MID = false;
    bf16_t* P; float* newk; float* newv; const float* rcos; const float* rsin;
    __device__ __forceinline__ void mid(f32x4 (&)[2][2][4][2], const Unit&, int, int, int, int) const {}
    __device__ __forceinline__ void operator()(const f32x4 (&acc)[2][2][4][2], const Unit& u, int wr, int wc, int fr_, int fq_) const {
        int fr = fr_, fq = fq_; asm volatile("" : "+v"(fr), "+v"(fq));
        const int row0 = u.pm * BM + wr * 64 + fr, col0 = u.pn * BM + wc * 32 + 8 * fq;
        const bool rope = (u.pn < 20) && (u.pm >= 32);
        const bool kout = (u.pm < 32) && (u.pn >= 16) && (u.pn < 20);
        const bool vout = (u.pm < 32) && (u.pn >= 20) && (u.pn < 24);
#pragma unroll
        for (int ai = 0; ai < 2; ++ai)
#pragma unroll
            for (int m = 0; m < 4; ++m) {
                const int row = row0 + ai * HALF + m * 16;
                f32x4 cs = (f32x4){1.f, 1.f, 1.f, 1.f}, sn = (f32x4){0.f, 0.f, 0.f, 0.f};
                if (rope) { const int pos = (row - NCTX) & 2047; cs = *(const f32x4*)(rcos + pos * 64 + 16 * wc + 4 * fq); sn = *(const f32x4*)(rsin + pos * 64 + 16 * wc + 4 * fq); }
                bf16_t* rowp = P + (size_t)row * INW + col0;
#pragma unroll
                for (int bj = 0; bj < 2; ++bj) {
                    f32x4 v0 = acc[ai][bj][m][0], v1 = acc[ai][bj][m][1];
                    if (kout) { float* kp = newk + (size_t)row * KVW + (u.pn - 16) * 256 + bj * HALF + 64 * (wc >> 1) + 16 * (wc & 1) + 4 * fq; *(f32x4*)kp = v0; *(f32x4*)(kp + 32) = v1; }
                    if (vout) { float* vp = newv + (size_t)row * KVW + (u.pn - 20) * 256 + bj * HALF + wc * 32 + 8 * fq; *(f32x4*)vp = v0; *(f32x4*)(vp + 4) = v1; }
                    if (rope) { const f32x4 o0 = v0 * cs - v1 * sn, o1 = v0 * sn + v1 * cs; v0 = o0; v1 = o1; }
                    __builtin_nontemporal_store(pack8(v0, v1), (u32x4*)(rowp + bj * HALF));
                }
            }
    }
};


struct EpiIn8 {
    typedef i32x4 acc_t;
    static constexpr bool PERM = true, HAS_MID = false;
    bf16_t* P; const float* sa; const float* sb; const float* rcos; const float* rsin;
    __device__ __forceinline__ void mid(i32x4 (&)[2][2][4][2], const Unit&, int, int, int, int) const {}
    __device__ __forceinline__ void operator()(const i32x4 (&acc)[2][2][4][2], const Unit& u, int wr, int wc, int fr_, int fq_) const {
        int fr = fr_, fq = fq_; asm volatile("" : "+v"(fr), "+v"(fq));
        const int row0 = u.pm * BM + wr * 64 + fr, col0 = u.pn * BM + wc * 32 + 8 * fq, bcol0 = u.pnb * BM + wc * 32 + 8 * fq;
        const bool rope = (u.pn < 16) && (u.pm >= 32);
        f32x4 cb[2][2];
#pragma unroll
        for (int bj = 0; bj < 2; ++bj)
#pragma unroll
            for (int n = 0; n < 2; ++n) cb[bj][n] = *(const f32x4*)(sb + bcol0 + bj * HALF + 4 * n);
#pragma unroll
        for (int ai = 0; ai < 2; ++ai)
#pragma unroll
            for (int m = 0; m < 4; ++m) {
                const int row = row0 + ai * HALF + m * 16; const float ra = sa[row];
                f32x4 cs = (f32x4){1.f, 1.f, 1.f, 1.f}, sn = (f32x4){0.f, 0.f, 0.f, 0.f};
                if (rope) { const int pos = (row - NCTX) & 2047; cs = *(const f32x4*)(rcos + pos * 64 + 16 * wc + 4 * fq); sn = *(const f32x4*)(rsin + pos * 64 + 16 * wc + 4 * fq); }
                bf16_t* rowp = P + (size_t)row * INW + col0;
#pragma unroll
                for (int bj = 0; bj < 2; ++bj) {
                    f32x4 v0 = __builtin_convertvector(acc[ai][bj][m][0], f32x4) * cb[bj][0] * ra, v1 = __builtin_convertvector(acc[ai][bj][m][1], f32x4) * cb[bj][1] * ra;
                    if (rope) { const f32x4 o0 = v0 * cs - v1 * sn, o1 = v0 * sn + v1 * cs; v0 = o0; v1 = o1; }
                    __builtin_nontemporal_store(pack8(v0, v1), (u32x4*)(rowp + bj * HALF));
                }
            }
    }
};

struct EpiMerge {
    typedef f32x4 acc_t;
    static constexpr bool PERM = true, HAS_MID = true;
    const bf16_t* P; bf16_t* O;
    __device__ __forceinline__ void mid(f32x4 (&acc)[2][2][4][2], const Unit& u, int wr, int wc, int fr_, int fq_) const {
        int fr = fr_, fq = fq_; asm volatile("" : "+v"(fr), "+v"(fq));
        const int row0 = u.pm * BM + wr * 64 + fr, col0 = u.pn * BM + wc * 32 + 8 * fq;
#pragma unroll
        for (int ai = 0; ai < 2; ++ai)
#pragma unroll
            for (int m = 0; m < 4; ++m) { const bf16_t* gp = P + (size_t)(row0 + ai * HALF + m * 16) * INW + col0;
#pragma unroll
                for (int bj = 0; bj < 2; ++bj) {
                    const u32x4 ga = *(const u32x4*)(gp + C_GA + bj * HALF), gc = *(const u32x4*)(gp + C_GC + bj * HALF);
#pragma unroll
                    for (int e = 0; e < 4; ++e) {
                        const float a0 = bf_lo(ga[e]), a1 = bf_hi(ga[e]), c0 = bf_lo(gc[e]), c1 = bf_hi(gc[e]);
                        const float r0 = (1.f + __expf(-c0)) * __builtin_amdgcn_rcpf(1.f + __expf(-a0)), r1 = (1.f + __expf(-c1)) * __builtin_amdgcn_rcpf(1.f + __expf(-a1));
                        acc[ai][bj][m][e >> 1][(e & 1) * 2] *= r0; acc[ai][bj][m][e >> 1][(e & 1) * 2 + 1] *= r1;
                    }
                }
                if (m == 3) asm volatile("" ::: "memory");
            }
    }
    __device__ __forceinline__ void operator()(const f32x4 (&acc)[2][2][4][2], const Unit& u, int wr, int wc, int fr_, int fq_) const {
        int fr = fr_, fq = fq_; asm volatile("" : "+v"(fr), "+v"(fq));
        const int row0 = u.pm * BM + wr * 64 + fr, col0 = u.pn * BM + wc * 32 + 8 * fq;
#pragma unroll
        for (int ai = 0; ai < 2; ++ai)
#pragma unroll
            for (int m = 0; m < 4; ++m) { const int row = row0 + ai * HALF + m * 16; const bf16_t* gp = P + (size_t)row * INW + col0 + C_GC; bf16_t* rowp = O + (size_t)row * DM + col0;
#pragma unroll
                for (int bj = 0; bj < 2; ++bj) {
                    const u32x4 gc = *(const u32x4*)(gp + bj * HALF);
                    f32x4 v0 = acc[ai][bj][m][0], v1 = acc[ai][bj][m][1];
                    v0[0] *= __builtin_amdgcn_rcpf(1.f + __expf(-bf_lo(gc[0]))); v0[1] *= __builtin_amdgcn_rcpf(1.f + __expf(-bf_hi(gc[0])));
                    v0[2] *= __builtin_amdgcn_rcpf(1.f + __expf(-bf_lo(gc[1]))); v0[3] *= __builtin_amdgcn_rcpf(1.f + __expf(-bf_hi(gc[1])));
                    v1[0] *= __builtin_amdgcn_rcpf(1.f + __expf(-bf_lo(gc[2]))); v1[1] *= __builtin_amdgcn_rcpf(1.f + __expf(-bf_hi(gc[2])));
                    v1[2] *= __builtin_amdgcn_rcpf(1.f + __expf(-bf_lo(gc[3]))); v1[3] *= __builtin_amdgcn_rcpf(1.f + __expf(-bf_hi(gc[3])));
                    *(u32x4*)(rowp + bj * HALF) = pack8(v0, v1);
                }
            }
    }
};


struct EpiT1 {
    typedef i32x4 acc_t;
    static constexpr bool PERM = true, HAS_MID = false;
    const bf16_t* P; bf16_t* O; const float* sa; const float* sb;
    __device__ __forceinline__ void mid(i32x4 (&)[2][2][4][2], const Unit&, int, int, int, int) const {}
    __device__ __forceinline__ void operator()(const i32x4 (&acc)[2][2][4][2], const Unit& u, int wr, int wc, int fr_, int fq_) const {
        int fr = fr_, fq = fq_; asm volatile("" : "+v"(fr), "+v"(fq));
        const int row0 = u.pm * BM + wr * 64 + fr, col0 = u.pn * BM + wc * 32 + 8 * fq;
        f32x4 cb[2][2];
#pragma unroll
        for (int bj = 0; bj < 2; ++bj)
#pragma unroll
            for (int n = 0; n < 2; ++n) cb[bj][n] = *(const f32x4*)(sb + col0 + bj * HALF + 4 * n);
#pragma unroll
        for (int ai = 0; ai < 2; ++ai)
#pragma unroll
            for (int m = 0; m < 4; ++m) { const int row = row0 + ai * HALF + m * 16; const float ra = sa[row]; const bf16_t* gp = P + (size_t)row * INW + col0 + C_GA; bf16_t* rowp = O + (size_t)row * DM + col0;
#pragma unroll
                for (int bj = 0; bj < 2; ++bj) {
                    const u32x4 ga = __builtin_nontemporal_load((const u32x4*)(gp + bj * HALF));
                    f32x4 v0 = __builtin_convertvector(acc[ai][bj][m][0], f32x4) * cb[bj][0] * ra, v1 = __builtin_convertvector(acc[ai][bj][m][1], f32x4) * cb[bj][1] * ra;
                    v0[0] *= __builtin_amdgcn_rcpf(1.f + __expf(-bf_lo(ga[0]))); v0[1] *= __builtin_amdgcn_rcpf(1.f + __expf(-bf_hi(ga[0])));
                    v0[2] *= __builtin_amdgcn_rcpf(1.f + __expf(-bf_lo(ga[1]))); v0[3] *= __builtin_amdgcn_rcpf(1.f + __expf(-bf_hi(ga[1])));
                    v1[0] *= __builtin_amdgcn_rcpf(1.f + __expf(-bf_lo(ga[2]))); v1[1] *= __builtin_amdgcn_rcpf(1.f + __expf(-bf_hi(ga[2])));
                    v1[2] *= __builtin_amdgcn_rcpf(1.f + __expf(-bf_lo(ga[3]))); v1[3] *= __builtin_amdgcn_rcpf(1.f + __expf(-bf_hi(ga[3])));
                    *(u32x4*)(rowp + bj * HALF) = pack8(v0, v1);
                }
            }
    }
};
struct EpiMerge2 {
    typedef f32x4 acc_t;
    static constexpr bool PERM = true, HAS_MID = false;
    const bf16_t* P; bf16_t* O;
    __device__ __forceinline__ void mid(f32x4 (&)[2][2][4][2], const Unit&, int, int, int, int) const {}
    __device__ __forceinline__ void operator()(const f32x4 (&acc)[2][2][4][2], const Unit& u, int wr, int wc, int fr_, int fq_) const {
        int fr = fr_, fq = fq_; asm volatile("" : "+v"(fr), "+v"(fq));
        const int row0 = u.pm * BM + wr * 64 + fr, col0 = u.pn * BM + wc * 32 + 8 * fq;
#pragma unroll
        for (int ai = 0; ai < 2; ++ai)
#pragma unroll
            for (int m = 0; m < 4; ++m) { const int row = row0 + ai * HALF + m * 16; const bf16_t* gp = P + (size_t)row * INW + col0 + C_GC; bf16_t* rowp = O + (size_t)row * DM + col0;
#pragma unroll
                for (int bj = 0; bj < 2; ++bj) {
                    const u32x4 gc = __builtin_nontemporal_load((const u32x4*)(gp + bj * HALF)), tp = *(const u32x4*)(rowp + bj * HALF);
                    f32x4 v0 = acc[ai][bj][m][0], v1 = acc[ai][bj][m][1];
                    v0[0] = bf_lo(tp[0]) + v0[0] * __builtin_amdgcn_rcpf(1.f + __expf(-bf_lo(gc[0]))); v0[1] = bf_hi(tp[0]) + v0[1] * __builtin_amdgcn_rcpf(1.f + __expf(-bf_hi(gc[0])));
                    v0[2] = bf_lo(tp[1]) + v0[2] * __builtin_amdgcn_rcpf(1.f + __expf(-bf_lo(gc[1]))); v0[3] = bf_hi(tp[1]) + v0[3] * __builtin_amdgcn_rcpf(1.f + __expf(-bf_hi(gc[1])));
                    v1[0] = bf_lo(tp[2]) + v1[0] * __builtin_amdgcn_rcpf(1.f + __expf(-bf_lo(gc[2]))); v1[1] = bf_hi(tp[2]) + v1[1] * __builtin_amdgcn_rcpf(1.f + __expf(-bf_hi(gc[2])));
                    v1[2] = bf_lo(tp[3]) + v1[2] * __builtin_amdgcn_rcpf(1.f + __expf(-bf_lo(gc[3]))); v1[3] = bf_hi(tp[3]) + v1[3] * __builtin_amdgcn_rcpf(1.f + __expf(-bf_hi(gc[3])));
                    *(u32x4*)(rowp + bj * HALF) = pack8(v0, v1);
                }
            }
    }
};

struct EpiUp {
    typedef i32x4 acc_t;
    static constexpr bool PERM = true, HAS_MID = false;
    bf16_t* F; const float* wconv; float* sbg; float* sbv; PG8_LAS float* halo; const float* sa; const float* sb;
    __device__ __forceinline__ void mid(i32x4 (&)[2][2][4][2], const Unit&, int, int, int, int) const {}
    __device__ __forceinline__ void operator()(const i32x4 (&acc)[2][2][4][2], const Unit& u, int wr, int wc, int fr_, int fq_) const {
        int fr = fr_, fq = fq_; asm volatile("" : "+v"(fr), "+v"(fq));
        const int colh = wc * 32 + 8 * fq, ch0 = u.pn * 128 + colh;
        f32x4 g[2][4][2], v[2][4][2];
        { f32x4 cg[2], cv[2];
#pragma unroll
          for (int n = 0; n < 2; ++n) { cg[n] = *(const f32x4*)(sb + u.pn * 256 + colh + 4 * n); cv[n] = *(const f32x4*)(sb + u.pn * 256 + HALF + colh + 4 * n); }
#pragma unroll
          for (int ai = 0; ai < 2; ++ai)
#pragma unroll
              for (int m = 0; m < 4; ++m) { const float ra = sa[u.pm * BM + ai * HALF + wr * 64 + m * 16 + fr];
#pragma unroll
                  for (int n = 0; n < 2; ++n) { g[ai][m][n] = __builtin_convertvector(acc[ai][0][m][n], f32x4) * cg[n] * ra; v[ai][m][n] = __builtin_convertvector(acc[ai][1][m][n], f32x4) * cv[n] * ra; } } }
#pragma unroll
        for (int ai = 0; ai < 2; ++ai) { const int sp = 2 * ai + wr;
            if (fr == 0)  { *(PG8_LAS f32x4*)(halo + (0 * 4 + sp) * 128 + colh) = g[ai][0][0]; *(PG8_LAS f32x4*)(halo + (0 * 4 + sp) * 128 + colh + 4) = g[ai][0][1]; }
            if (fr == 15) { *(PG8_LAS f32x4*)(halo + (1 * 4 + sp) * 128 + colh) = g[ai][3][0]; *(PG8_LAS f32x4*)(halo + (1 * 4 + sp) * 128 + colh + 4) = g[ai][3][1]; } }
        asm volatile("s_waitcnt lgkmcnt(0)" ::: "memory"); __builtin_amdgcn_s_barrier(); asm volatile("" ::: "memory");
        if (u.pm >= 32) {
            if (wr == 0 && fr < 2) { float* p = sbg + ((size_t)u.pm * 4 + fr) * DFF + ch0; *(f32x4*)p = g[0][0][0]; *(f32x4*)(p + 4) = g[0][0][1];
                if (fr == 0) { float* q = sbv + ((size_t)u.pm * 2) * DFF + ch0; *(f32x4*)q = v[0][0][0]; *(f32x4*)(q + 4) = v[0][0][1]; } }
            if (wr == 1 && fr >= 14) { float* p = sbg + ((size_t)u.pm * 4 + 2 + (fr - 14)) * DFF + ch0; *(f32x4*)p = g[1][3][0]; *(f32x4*)(p + 4) = g[1][3][1];
                if (fr == 15) { float* q = sbv + ((size_t)u.pm * 2 + 1) * DFF + ch0; *(f32x4*)q = v[1][3][0]; *(f32x4*)(q + 4) = v[1][3][1]; } }
        }
        f32x4 w0[2], w1[2], w2[2];
#pragma unroll
        for (int n = 0; n < 2; ++n) { w0[n] = *(const f32x4*)(wconv + ch0 + 4 * n); w1[n] = *(const f32x4*)(wconv + DFF + ch0 + 4 * n); w2[n] = *(const f32x4*)(wconv + 2 * DFF + ch0 + 4 * n); }
#define DPP_F(oldv, srcv, ctrl) __builtin_bit_cast(float, __builtin_amdgcn_update_dpp(__builtin_bit_cast(int, (float)(oldv)), __builtin_bit_cast(int, (float)(srcv)), (ctrl), 0xf, 0xf, false))
#pragma unroll
        for (int ai = 0; ai < 2; ++ai) { const int sp = 2 * ai + wr;
            f32x4 hup[2], hdn[2];
#pragma unroll
            for (int n = 0; n < 2; ++n) {
                hup[n] = (sp > 0) ? *(const PG8_LAS f32x4*)(halo + (1 * 4 + sp - 1) * 128 + colh + 4 * n) : (f32x4){0.f, 0.f, 0.f, 0.f};
                hdn[n] = (sp < 3) ? *(const PG8_LAS f32x4*)(halo + (0 * 4 + sp + 1) * 128 + colh + 4 * n) : (f32x4){0.f, 0.f, 0.f, 0.f}; }
#pragma unroll
            for (int m = 0; m < 4; ++m) {
                f32x4 o[2];
#pragma unroll
                for (int n = 0; n < 2; ++n)
#pragma unroll
                    for (int j = 0; j < 4; ++j) {
                        const float gg = g[ai][m][n][j];
                        float ub, db;
                        if (m > 0) ub = DPP_F(0.f, g[ai][m > 0 ? m - 1 : 0][n][j], 0x121); else ub = hup[n][j];
                        if (m < 3) db = DPP_F(0.f, g[ai][m < 3 ? m + 1 : 3][n][j], 0x12f); else db = hdn[n][j];
                        const float up = DPP_F(ub, gg, 0x111), dn = DPP_F(db, gg, 0x101);
                        const float cv = w0[n][j] * up + w1[n][j] * gg + w2[n][j] * dn;
                        o[n][j] = cv * __builtin_amdgcn_rcpf(1.f + __expf(-cv)) * v[ai][m][n][j];
                    }
                __builtin_nontemporal_store(pack8(o[0], o[1]), (u32x4*)(F + (size_t)(u.pm * BM + ai * HALF + wr * 64 + m * 16 + fr) * DFF + ch0));
            }
        }
#undef DPP_F
    }
};

template <class Epi, class Sched, bool ALIGN_EPI, bool I8 = false>
__device__ __forceinline__ void gemm_phase(PG8_LAS unsigned char* lds, const Gemm g, const Sched& S, const Epi& E, const int tid) {
    typedef typename Epi::acc_t acc_t;
    const int wid = __builtin_amdgcn_readfirstlane(tid >> 6), lane = tid & 63, wr = wid >> 2, wc = wid & 3, fr = lane & 15, fq = lane >> 4;
    const int K = g.K, rbA = I8 ? g.lda : g.lda * 2, rbB = I8 ? K : K * 2, nt = rbB / (BK * 2);
    unsigned voffA[2], voffB[2];
#pragma unroll
    for (int i = 0; i < 2; ++i) { int R, C; stage_rc(tid * 16 + i * 8192, R, C); const int Rb = Epi::PERM ? ((R & ~31) + perm32(R & 31)) : R;
        voffA[i] = (unsigned)(R * rbA + C * 2); voffB[i] = (unsigned)(Rb * rbB + C * 2); }
    const size_t kstep = (size_t)(BK * 2);
    const size_t hstepA = (size_t)HALF * rbA, hstepB = (size_t)HALF * rbB;
    const size_t tstepA = 2 * hstepA, tstepB = 2 * hstepB;
    const unsigned ldsw = (unsigned)wid * 1024u;
    const int aoff = lds_byte(wr * 64 + fr, fq * 8), boff = lds_byte(wc * 32 + fr, fq * 8);
#define PG8_KOFF(kt) ((size_t)(kt) * kstep + (((kt) >= g.kj_t) ? (size_t)g.kj_bytes : (size_t)0))
#define PG8_SA(b, h) (((b) * 2 + (h)) * HTB)
#define PG8_SB(b, h) ((4 + (b) * 2 + (h)) * HTB)
#define PG8_STAGE(bufoff, gbase, voff) do { _Pragma("unroll") for (int _i = 0; _i < 2; ++_i) \
        __builtin_amdgcn_global_load_lds((const unsigned*)((const char*)(gbase) + (voff)[_i]), (PG8_LAS unsigned*)(lds + (bufoff) + ldsw + _i * 8192), 16, 0, 0); } while (0)
#define PG8_LDA(dst, b, h) do { _Pragma("unroll") for (int m = 0; m < 4; ++m) _Pragma("unroll") for (int k = 0; k < 2; ++k) dst[m][k] = *(const PG8_LAS bf16x8*)(lds + PG8_SA(b, h) + aoff + m * 2048 + k * 1024); } while (0)
#define PG8_LDB(dst, b, h) do { _Pragma("unroll") for (int n = 0; n < 2; ++n) _Pragma("unroll") for (int k = 0; k < 2; ++k) dst[n][k] = *(const PG8_LAS bf16x8*)(lds + PG8_SB(b, h) + boff + n * 2048 + k * 1024); } while (0)
#define PG8_MMA(ai, bj, At, Bt) do { __builtin_amdgcn_s_setprio(1); _Pragma("unroll") for (int m = 0; m < 4; ++m) _Pragma("unroll") for (int n = 0; n < 2; ++n) _Pragma("unroll") for (int k = 0; k < 2; ++k) { \
        if constexpr (I8) acc[ai][bj][m][n] = __builtin_amdgcn_mfma_i32_16x16x64_i8(__builtin_bit_cast(i32x4, Bt[n][k]), __builtin_bit_cast(i32x4, At[m][k]), acc[ai][bj][m][n], 0, 0, 0); \
        else acc[ai][bj][m][n] = __builtin_amdgcn_mfma_f32_16x16x32_bf16(Bt[n][k], At[m][k], acc[ai][bj][m][n], 0, 0, 0); } __builtin_amdgcn_s_setprio(0); } while (0)
#define PG8_WAIT_V(n) asm volatile("s_waitcnt vmcnt(" #n ")" ::: "memory")
#define PG8_WAIT_L(n) asm volatile("s_waitcnt lgkmcnt(" #n ")" ::: "memory")
#define PG8_BAR __builtin_amdgcn_s_barrier()
#define PG8_SCHED __builtin_amdgcn_sched_barrier(0)
    Unit cur, nxt; int ui = 0;
    if (!S.next(0, cur)) return;
    acc_t acc[2][2][4][2];
#pragma unroll
    for (int a = 0; a < 2; ++a)
#pragma unroll
        for (int b = 0; b < 2; ++b)
#pragma unroll
            for (int m = 0; m < 4; ++m)
#pragma unroll
                for (int n = 0; n < 2; ++n) acc[a][b][m][n] = (acc_t){0, 0, 0, 0};
    bf16x8 At[4][2], B0[2][2], B1[2][2];
    const char* cA = (const char*)g.A + (size_t)cur.pm * tstepA; const char* cB = (const char*)g.Bt + (size_t)cur.pnb * tstepB;
    S.a_ready(cur);
    PG8_STAGE(PG8_SB(0, 0), cB, voffB); PG8_STAGE(PG8_SB(0, 1), cB + hstepB, voffB); PG8_STAGE(PG8_SA(0, 0), cA, voffA); PG8_STAGE(PG8_SA(0, 1), cA + hstepA, voffA);
    if (wr == 1) PG8_BAR;
    PG8_WAIT_V(2); PG8_BAR;
    PG8_STAGE(PG8_SB(1, 0), cB + kstep, voffB); PG8_STAGE(PG8_SA(1, 0), cA + kstep, voffA); PG8_STAGE(PG8_SB(1, 1), cB + hstepB + kstep, voffB);
    PG8_WAIT_V(6); PG8_BAR;
    for (;;) {
        const bool has_next = S.next(ui + 1, nxt);
        const char* nA = has_next ? (const char*)g.A + (size_t)nxt.pm * tstepA : cA; const char* nB = has_next ? (const char*)g.Bt + (size_t)nxt.pnb * tstepB : cB;
        for (int t = 0; t < nt; t += 2) {
            const bool last = (t == nt - 2);
            if constexpr (Epi::HAS_MID) { if (t == g.kj_t) E.mid(acc, cur, wr, wc, fr, fq); }
            const char* a1 = cA + PG8_KOFF(t + 1);
            const char* a2 = last ? nA : cA + PG8_KOFF(t + 2); const char* b2 = last ? nB : cB + (size_t)(t + 2) * kstep;
            const char* a3 = a2 + kstep; const char* b3 = b2 + kstep;
            if (last && has_next) S.a_ready(nxt);
            PG8_LDB(B0, 0, 0); PG8_LDB(B1, 0, 1); PG8_SCHED; PG8_LDA(At, 0, 0); PG8_STAGE(PG8_SA(1, 1), a1 + hstepA, voffA);
            PG8_WAIT_V(8); PG8_WAIT_L(0); PG8_BAR; PG8_MMA(0, 0, At, B0); PG8_MMA(0, 1, At, B1); PG8_BAR; PG8_SCHED;
            PG8_LDA(At, 0, 1); PG8_STAGE(PG8_SB(0, 0), b2, voffB); PG8_STAGE(PG8_SB(0, 1), b2 + hstepB, voffB); PG8_STAGE(PG8_SA(0, 0), a2, voffA);
            PG8_WAIT_V(8); PG8_WAIT_L(0); PG8_BAR; PG8_MMA(1, 0, At, B0); PG8_MMA(1, 1, At, B1); PG8_BAR; PG8_SCHED;
            PG8_LDB(B0, 1, 0); PG8_LDB(B1, 1, 1); PG8_SCHED; PG8_LDA(At, 1, 0); PG8_STAGE(PG8_SA(0, 1), a2 + hstepA, voffA);
            PG8_WAIT_V(8); PG8_WAIT_L(0); PG8_BAR; PG8_MMA(0, 0, At, B0); PG8_MMA(0, 1, At, B1); PG8_BAR; PG8_SCHED;
            PG8_LDA(At, 1, 1); PG8_STAGE(PG8_SB(1, 0), b3, voffB); PG8_STAGE(PG8_SB(1, 1), b3 + hstepB, voffB); PG8_STAGE(PG8_SA(1, 0), a3, voffA);
            PG8_WAIT_V(8); PG8_WAIT_L(0); PG8_BAR; PG8_MMA(1, 0, At, B0); PG8_MMA(1, 1, At, B1); PG8_BAR; PG8_SCHED;
        }
        if constexpr (ALIGN_EPI) { if (wr == 0) PG8_BAR; }
        E(acc, cur, wr, wc, fr, fq); S.done(cur);
        if (!has_next) break;
#pragma unroll
        for (int a = 0; a < 2; ++a)
#pragma unroll
            for (int b = 0; b < 2; ++b)
#pragma unroll
                for (int m = 0; m < 4; ++m)
#pragma unroll
                    for (int n = 0; n < 2; ++n) acc[a][b][m][n] = (acc_t){0, 0, 0, 0};
        cur = nxt; cA = nA; cB = nB; ++ui;
        if constexpr (ALIGN_EPI) { if (wr == 1) PG8_BAR; }
    }
    PG8_WAIT_V(0);
    if constexpr (!ALIGN_EPI) { if (wr == 0) PG8_BAR; }
    PG8_BAR;
#undef PG8_KOFF
#undef PG8_SA
#undef PG8_SB
#undef PG8_STAGE
#undef PG8_LDA
#undef PG8_LDB
#undef PG8_MMA
#undef PG8_WAIT_V
#undef PG8_WAIT_L
#undef PG8_BAR
#undef PG8_SCHED
}
}

namespace att {
typedef unsigned short bf16_t;
using bf16x8 = __attribute__((ext_vector_type(8))) short;
using s16x4  = __attribute__((ext_vector_type(4))) short;
using f32x16 = __attribute__((ext_vector_type(16))) float;
using u32x4  = __attribute__((ext_vector_type(4))) unsigned;
constexpr int D = 128, KVBLK = 64;
constexpr float SCALE = 0.088388347648318440f, THR = 8.f;
constexpr int SHM_V = KVBLK * D * 2, SHM_K = KVBLK * D * 2, SHM_ATTN = 2 * SHM_V + 2 * SHM_K + 8 * 64 * 4;
#define KSWZ(row, colB) ((row) * 256 + ((colB) ^ (((row) & 7) << 4)))
#define SBAR() __builtin_amdgcn_sched_barrier(0)
__device__ __forceinline__ int crow(int r, int hi) { return (r & 3) + 8 * (r >> 2) + 4 * hi; }
__device__ __forceinline__ unsigned cvtpk(float lo, float hi) { unsigned r; asm volatile("v_cvt_pk_bf16_f32 %0, %1, %2" : "=v"(r) : "v"(lo), "v"(hi)); return r; }
__device__ __forceinline__ bf16x8 ld8(const bf16_t* p) { return *reinterpret_cast<const bf16x8*>(p); }

__device__ __forceinline__ void partialSM(f32x16& p0, f32x16& p1, float& m_reg, float& mn, float& alpha) {
  constexpr float C = SCALE * 1.4426950408889634f;
  float pmax = p0[0];
#pragma unroll
  for (int r = 1; r < 16; ++r) pmax = fmaxf(pmax, p0[r]);
#pragma unroll
  for (int r = 0; r < 16; ++r) pmax = fmaxf(pmax, p1[r]);
  { auto rr = __builtin_amdgcn_permlane32_swap(__float_as_uint(pmax), __float_as_uint(pmax), false, false);
    pmax = fmaxf(__uint_as_float(rr[0]), __uint_as_float(rr[1])); }
  if (__builtin_expect(__all(pmax - m_reg <= THR / SCALE), 1)) { mn = m_reg; alpha = 1.f; }
  else { mn = fmaxf(m_reg, pmax); alpha = __builtin_amdgcn_exp2f((m_reg - mn) * C); m_reg = mn; }
  float mnC = -mn * C;
#pragma unroll
  for (int r = 0; r < 16; ++r) p0[r] = fmaf(p0[r], C, mnC);
#pragma unroll
  for (int r = 0; r < 16; ++r) p1[r] = fmaf(p1[r], C, mnC);
#pragma unroll
  for (int r = 0; r < 16; ++r) p0[r] = __builtin_amdgcn_exp2f(p0[r]);
}
__device__ __forceinline__ void finishSM(f32x16& p0, f32x16& p1, float alpha, float& l_reg, bf16x8& pa0, bf16x8& pa1, bf16x8& pa2, bf16x8& pa3) {
#pragma unroll
  for (int r = 0; r < 16; ++r) p1[r] = __builtin_amdgcn_exp2f(p1[r]);
  float ps = 0;
#pragma unroll
  for (int r = 0; r < 16; ++r) ps += p0[r];
#pragma unroll
  for (int r = 0; r < 16; ++r) ps += p1[r];
  { auto rr = __builtin_amdgcn_permlane32_swap(__float_as_uint(ps), __float_as_uint(ps), false, false);
    ps = __uint_as_float(rr[0]) + __uint_as_float(rr[1]); }
  l_reg = l_reg * alpha + ps;
#define PK4(P, BASE, OUT) do { unsigned a0 = cvtpk(P[BASE + 0], P[BASE + 1]), a1 = cvtpk(P[BASE + 2], P[BASE + 3]);   \
    unsigned b0 = cvtpk(P[BASE + 4], P[BASE + 5]), b1 = cvtpk(P[BASE + 6], P[BASE + 7]);                              \
    auto r0 = __builtin_amdgcn_permlane32_swap(a0, b0, false, false); auto r1 = __builtin_amdgcn_permlane32_swap(a1, b1, false, false); \
    u32x4 w = {r0[0], r1[0], r0[1], r1[1]}; OUT = *reinterpret_cast<bf16x8*>(&w); } while (0)
  PK4(p0, 0, pa0); PK4(p0, 8, pa1); PK4(p1, 0, pa2); PK4(p1, 8, pa3);
#undef PK4
}
__device__ __forceinline__ void qkt(f32x16& p0, f32x16& p1, const char* Ks, const bf16x8* qr, int r32, int hi) {
  p0 = f32x16{}; p1 = f32x16{};
#pragma unroll
  for (int d0 = 0; d0 < 8; ++d0) { int cb = (d0 * 16 + hi * 8) * 2;
    bf16x8 b0 = *reinterpret_cast<const bf16x8*>(Ks + KSWZ(r32, cb));
    bf16x8 b1 = *reinterpret_cast<const bf16x8*>(Ks + KSWZ(32 + r32, cb));
    p0 = __builtin_amdgcn_mfma_f32_32x32x16_bf16(b0, qr[d0], p0, 0, 0, 0);
    p1 = __builtin_amdgcn_mfma_f32_32x32x16_bf16(b1, qr[d0], p1, 0, 0, 0); }
}
__device__ __forceinline__ int v_st(int k, int c) { const int kk = (k & ~0xC) | ((k & 4) << 1) | ((k & 8) >> 1); return ((kk >> 3) * 4 + (c >> 5)) * 512 + ((kk & 7) * 32 + (c & 31)) * 2; }
__device__ __forceinline__ int v_rd_base(int lane) { return ((lane & 3) << 3) | (((lane >> 2) & 3) << 6) | (((lane >> 4) & 1) << 5) | (((lane >> 5) & 1) << 8); }
constexpr int v_rd_off(int d0, int ks, int half) { return d0 * 512 + ks * 4096 + half * 2048; }
template <int OFF> __device__ __forceinline__ s16x4 tr_read(int vb) {
  s16x4 r; asm volatile("ds_read_b64_tr_b16 %0, %1 offset:%2" : "=&v"(r) : "v"(vb), "i"(OFF) : "memory"); return r;
}
template <int D0> __device__ __forceinline__ void pv_one(f32x16& od, int vb, bf16x8 pa0, bf16x8 pa1, bf16x8 pa2, bf16x8 pa3) {
  const s16x4 l0 = tr_read<v_rd_off(D0, 0, 0)>(vb), h0 = tr_read<v_rd_off(D0, 0, 1)>(vb), l1 = tr_read<v_rd_off(D0, 1, 0)>(vb), h1 = tr_read<v_rd_off(D0, 1, 1)>(vb);
  const s16x4 l2 = tr_read<v_rd_off(D0, 2, 0)>(vb), h2 = tr_read<v_rd_off(D0, 2, 1)>(vb), l3 = tr_read<v_rd_off(D0, 3, 0)>(vb), h3 = tr_read<v_rd_off(D0, 3, 1)>(vb);
  asm volatile("s_waitcnt lgkmcnt(0)" ::: "memory"); SBAR();
#define PK(L, H) (bf16x8){L[0], L[1], L[2], L[3], H[0], H[1], H[2], H[3]}
  od = __builtin_amdgcn_mfma_f32_32x32x16_bf16(pa0, PK(l0, h0), od, 0, 0, 0);
  od = __builtin_amdgcn_mfma_f32_32x32x16_bf16(pa1, PK(l1, h1), od, 0, 0, 0);
  od = __builtin_amdgcn_mfma_f32_32x32x16_bf16(pa2, PK(l2, h2), od, 0, 0, 0);
  od = __builtin_amdgcn_mfma_f32_32x32x16_bf16(pa3, PK(l3, h3), od, 0, 0, 0);
#undef PK
}
__device__ __forceinline__ void pv_d0(f32x16* o, int vb, bf16x8 pa0, bf16x8 pa1, bf16x8 pa2, bf16x8 pa3) {
  pv_one<0>(o[0], vb, pa0, pa1, pa2, pa3); pv_one<1>(o[1], vb, pa0, pa1, pa2, pa3); pv_one<2>(o[2], vb, pa0, pa1, pa2, pa3); pv_one<3>(o[3], vb, pa0, pa1, pa2, pa3);
}
__device__ __forceinline__ void band_mask(f32x16& p0, f32x16& p1, int dq, int hi) {
#pragma unroll
  for (int r = 0; r < 16; ++r) { const int d = dq - crow(r, hi); if (d > 128 || d < -128) p0[r] = -1e30f; const int d2 = d - 32; if (d2 > 128 || d2 < -128) p1[r] = -1e30f; }
}

struct Src { const bf16_t* KA; const bf16_t* VA; int nA; const bf16_t* KB; const bf16_t* VB; int nB; int qpos0, kpos0, masked; };

__device__ __forceinline__ void attn_unit(const bf16_t* __restrict__ Qw, bf16_t* __restrict__ Ow, const Src S, float sink, char* lds, const int tid, const int ldo) {
  const int wid = tid >> 6, lane = tid & 63, r32 = lane & 31, hi = lane >> 5;
  char* V_lds = lds; char* K_lds = lds + 2 * SHM_V;
  float* ws = (float*)(lds + 2 * SHM_V + 2 * SHM_K) + wid * 64; float* li_l = ws; float* al_l = ws + 32;
  float m_reg = sink * (1.f / SCALE), l_reg = 1.f; f32x16 o[4] = {}; bf16x8 qr[8];
#pragma unroll
  for (int d0 = 0; d0 < 8; ++d0) qr[d0] = ld8(Qw + d0 * 16);
  const int sr = tid >> 4, sc = (tid & 15) * 8, vst0 = v_st(sr, sc), vst1 = v_st(32 + sr, sc);
  const int vb0 = (int)(uintptr_t)V_lds + v_rd_base(lane);
  const int qpos = S.qpos0 + 32 * (wid & 3) + r32;
  struct { bf16x8 vs0, vs1, ks0, ks1; } sr_[2];
#define SLOAD(i, t) do { const int _t = (t); const bool _a = _t < S.nA; const int _ld = _a ? KVW : INW; \
    const size_t _o = _a ? (size_t)_t * (64 * KVW) : (size_t)(_t - S.nA) * ((size_t)64 * INW); \
    const bf16_t* _k = (_a ? S.KA : S.KB) + _o + (size_t)sr * _ld + sc; const bf16_t* _v = (_a ? S.VA : S.VB) + _o + (size_t)sr * _ld + sc; \
    sr_[i].vs0 = ld8(_v); sr_[i].vs1 = ld8(_v + (size_t)32 * _ld); sr_[i].ks0 = ld8(_k); sr_[i].ks1 = ld8(_k + (size_t)32 * _ld); } while (0)
#define SWRITE(b, i) do { *(bf16x8*)(V_lds + (b) * SHM_V + vst0) = sr_[i].vs0;          \
    *(bf16x8*)(V_lds + (b) * SHM_V + vst1) = sr_[i].vs1; int kc = sc * 2;               \
    *(bf16x8*)(K_lds + (b) * SHM_K + KSWZ(sr, kc)) = sr_[i].ks0;                       \
    *(bf16x8*)(K_lds + (b) * SHM_K + KSWZ(32 + sr, kc)) = sr_[i].ks1; } while (0)
#define SWAIT() asm volatile("s_waitcnt vmcnt(4)" ::: "memory")
#define RESC(a) do { if (__any((a) < 1.f)) { if (hi == 0) al_l[r32] = (a); asm volatile("s_waitcnt lgkmcnt(0)" ::: "memory"); \
    _Pragma("unroll") for (int d = 0; d < 4; ++d) _Pragma("unroll") for (int r = 0; r < 16; ++r) o[d][r] *= al_l[crow(r, hi)]; } } while (0)
#define MASK(P0, P1, t) do { const int _t = (t); if (S.masked && _t >= S.nA) { const int _kp0 = S.kpos0 + 64 * (_t - S.nA); \
    if ((_kp0 >> 7) != (S.qpos0 >> 7)) band_mask(P0, P1, qpos - _kp0, hi); } } while (0)
  f32x16 pA0, pA1, pB0, pB1; float mnA, mnB, alA, alB; bf16x8 pa0, pa1, pa2, pa3; const int NT = S.nA + S.nB;
  constexpr int SE = 0, SO = 1;
  SLOAD(SE, 0); asm volatile("s_waitcnt vmcnt(0)" ::: "memory"); SWRITE(0, SE); __syncthreads();
  qkt(pA0, pA1, K_lds, qr, r32, hi); MASK(pA0, pA1, 0); partialSM(pA0, pA1, m_reg, mnA, alA);
  SLOAD(SO, 1); if (2 < NT) SLOAD(SE, 2);
  SWAIT(); SWRITE(1, SO); __syncthreads();
  for (int j = 1; j + 1 < NT; j += 2) {
    SBAR(); qkt(pB0, pB1, K_lds + SHM_K, qr, r32, hi);
    finishSM(pA0, pA1, alA, l_reg, pa0, pa1, pa2, pa3); SBAR();
    SLOAD(SO, j + 2); SBAR();
    pv_d0(o, vb0, pa0, pa1, pa2, pa3); MASK(pB0, pB1, j); partialSM(pB0, pB1, m_reg, mnB, alB);
    __syncthreads(); SWAIT(); SWRITE(0, SE);
    RESC(alB); __syncthreads();
    SBAR(); qkt(pA0, pA1, K_lds, qr, r32, hi);
    finishSM(pB0, pB1, alB, l_reg, pa0, pa1, pa2, pa3); SBAR();
    if (j + 3 < NT) SLOAD(SE, j + 3); SBAR();
    pv_d0(o, vb0 + (int)SHM_V, pa0, pa1, pa2, pa3); MASK(pA0, pA1, j + 1); partialSM(pA0, pA1, m_reg, mnA, alA);
    __syncthreads(); SWAIT(); SWRITE(1, SO);
    RESC(alA); __syncthreads();
  }
  SBAR(); qkt(pB0, pB1, K_lds + SHM_K, qr, r32, hi);
  finishSM(pA0, pA1, alA, l_reg, pa0, pa1, pa2, pa3); SBAR();
  pv_d0(o, vb0, pa0, pa1, pa2, pa3); MASK(pB0, pB1, NT - 1); partialSM(pB0, pB1, m_reg, mnB, alB);
  __syncthreads(); RESC(alB);
  finishSM(pB0, pB1, alB, l_reg, pa0, pa1, pa2, pa3); SBAR();
  pv_d0(o, vb0 + (int)SHM_V, pa0, pa1, pa2, pa3);
  if (hi == 0) li_l[r32] = l_reg; asm volatile("s_waitcnt lgkmcnt(0)" ::: "memory");
  float rli[16];
#pragma unroll
  for (int r = 0; r < 16; ++r) rli[r] = __builtin_amdgcn_rcpf(li_l[crow(r, hi)]);
  { char* stg = lds + SHM_ATTN + wid * 4096;
#pragma unroll
    for (int p = 0; p < 2; ++p) {
#pragma unroll
      for (int rr = 0; rr < 8; ++rr) { const int r = 8 * p + rr, lrow = (rr & 3) + 8 * (rr >> 2) + 4 * hi;
#pragma unroll
        for (int d0 = 0; d0 < 4; ++d0) *(bf16_t*)(stg + lrow * 256 + (d0 * 32 + r32) * 2) = (bf16_t)(cvtpk(o[d0][r] * rli[r], 0.f) & 0xffffu); }
      asm volatile("s_waitcnt lgkmcnt(0)" ::: "memory");
#pragma unroll
      for (int k = 0; k < 4; ++k) { const int row = 4 * k + (lane >> 4), chunk = lane & 15;
        const u32x4 v = *(const u32x4*)(stg + row * 256 + chunk * 16);
        *(u32x4*)(Ow + (size_t)(16 * p + row) * ldo + chunk * 8) = v; }
      asm volatile("s_waitcnt lgkmcnt(0)" ::: "memory");
    } }
#undef SLOAD
#undef SWRITE
#undef SWAIT
#undef RESC
#undef MASK
}
}

#ifndef MK_N_LAUNCHES
#define MK_N_LAUNCHES 1
#endif
constexpr int N_PHASES = 11;
constexpr int N_LAUNCHES = MK_N_LAUNCHES;
constexpr int NWAVES = 8;

constexpr size_t MiB = 1u << 20;
constexpr size_t WS_CTL = 0, CTL_ZERO_BYTES = 262144;
constexpr size_t WS_MOD = 1 * MiB;
constexpr size_t WS_ROPE = 2 * MiB;
constexpr size_t WS_CK = 4 * MiB, WS_CV = 12 * MiB;
constexpr size_t WS_WCAT = 20 * MiB;
constexpr size_t WS_WA8 = 36 * MiB;
constexpr size_t WS_SB3 = 52 * MiB;
constexpr size_t WS_WMIX = 68 * MiB;
constexpr size_t WS_WUP8 = 100 * MiB;
constexpr size_t WS_SB2 = 229 * MiB;
constexpr size_t WS_WDN = 272 * MiB;
constexpr size_t WS_H = 358 * MiB;
constexpr size_t WS_WIN = 550 * MiB;
constexpr size_t WS_H8 = 614 * MiB;
constexpr size_t WS_PROJ = 710 * MiB;
constexpr size_t WS_F = 1226 * MiB;
constexpr size_t WS_SBG = 1742 * MiB;
constexpr size_t WS_SBV = 1760 * MiB;
constexpr size_t WS_W8 = 1670 * MiB;
constexpr size_t WS_SA = 53 * MiB, WS_SB = 54 * MiB;
constexpr size_t WS_END = 1770 * MiB;
static_assert(WS_WCAT + (size_t)4096 * 2048 * 2 <= WS_WA8 && WS_WA8 + (size_t)4096 * 4096 <= WS_SB3 && WS_SB3 + 4096 * 4 <= WS_WMIX && WS_WMIX + (size_t)4096 * 4096 * 2 <= WS_WUP8 && WS_WUP8 + (size_t)UPW * 4096 <= WS_SB2 && WS_SB2 + UPW * 4 <= WS_WDN &&
              WS_WDN + (size_t)4096 * DFF * 2 <= WS_H && WS_H + (size_t)MTOT * DM * 2 <= WS_WIN && WS_WIN + (size_t)8192 * 4096 * 2 <= WS_H8 && WS_H8 + (size_t)MTOT * DM <= WS_PROJ && WS_W8 + (size_t)12288 * 4096 <= WS_SBG && WS_SB3 + 4096 * 4 <= WS_SA && WS_SB + 12288 * 4 <= WS_WMIX &&
              WS_PROJ + (size_t)MTOT * INW * 2 <= WS_W8 && WS_F + (size_t)MTOT * DFF * 2 <= WS_SBG && WS_SBG + (size_t)96 * 4 * DFF * 4 <= WS_SBV && WS_SBV + (size_t)96 * 2 * DFF * 4 <= WS_END && WS_SA + MTOT * 4 <= WS_SB && WS_CV + 8 * MiB <= WS_WCAT, "d_ws map");
constexpr int CW_BAR = 4096;
constexpr int CW_CMAX = 16384;
constexpr int CW_CMAX2 = CW_CMAX + 12288;
constexpr int CW_CMAX3 = CW_CMAX2 + 22016;
static_assert((CW_BAR + 3456) <= CW_CMAX && (CW_CMAX3 + 4096) * 4 <= (int)CTL_ZERO_BYTES, "control words inside the per-call memset");
constexpr size_t O_NK = (size_t)MTOT * DM, O_NV = O_NK + (size_t)NCTX * KVW, O_END = O_NV + (size_t)NCTX * KVW;

constexpr int RING_BYTES = 131072, MISC_OFF = RING_BYTES + 320, LDS_BYTES = 147456;

#define LAS __attribute__((address_space(3)))
typedef unsigned short bf16;
typedef float f32x4 __attribute__((ext_vector_type(4)));
typedef unsigned u32x4 __attribute__((ext_vector_type(4)));
typedef unsigned u32x2 __attribute__((ext_vector_type(2)));

#define XB_TMO      128
#define XB_XCNT(j)  (256  + 64 * (j))
#define XB_XSUB(j)  (1280 + 64 * (j))
#define XB_XGEN(j)  (2304 + 64 * (j))
#define XB_TOP      3328
#define XB_TOPGEN   3392
#define XCD_BAR_WORDS 3456
#define XB_SPIN_CAP (1u << 22)
__device__ __forceinline__ unsigned xb_ld(unsigned* p)              { return __hip_atomic_load(p, __ATOMIC_RELAXED, __HIP_MEMORY_SCOPE_AGENT); }
__device__ __forceinline__ unsigned xb_add(unsigned* p, unsigned v) { return __hip_atomic_fetch_add(p, v, __ATOMIC_RELAXED, __HIP_MEMORY_SCOPE_AGENT); }
__device__ __forceinline__ unsigned xb_xcc_id() { return (unsigned)__builtin_amdgcn_s_getreg((3 << 11) | 20) & 0xFu; }
#define XB_SPIN(cond, bar) do { unsigned _sp = 0; while (cond) { __builtin_amdgcn_s_sleep(1); \
    if ((++_sp & 255u) == 0u) { if (xb_ld(&(bar)[XB_TMO])) break; if (_sp > XB_SPIN_CAP) { atomicAdd(&(bar)[XB_TMO], 1u); break; } } } } while (0)
struct XcdBarrier { unsigned* bar; unsigned x; volatile LAS unsigned* st; };
__device__ __forceinline__ XcdBarrier xcd_barrier_post(unsigned* bar, volatile LAS unsigned* st, const int tid) {
    XcdBarrier b; b.bar = bar; b.x = xb_xcc_id(); b.st = st;
    if (tid == 0) (void)xb_add(&bar[XB_XCNT(b.x)], 1u);
    return b;
}
__device__ __forceinline__ void xcd_barrier_complete(unsigned* bar, unsigned x, unsigned& nloc, unsigned& nx) {
    const unsigned G = gridDim.x * gridDim.y * gridDim.z;
    unsigned sum, cnt, mine, sp = 0u;
    for (;;) {
        sum = 0u; cnt = 0u; mine = 0u;
#pragma unroll
        for (unsigned j = 0; j < 16; ++j) { const unsigned c = xb_ld(&bar[XB_XCNT(j)]); sum += c; cnt += (c > 0u) ? 1u : 0u; mine = (j == x) ? c : mine; }
        if (sum == G) break;
        __builtin_amdgcn_s_sleep(1);
        if ((++sp & 255u) == 0u) { if (xb_ld(&bar[XB_TMO])) break; if (sp > XB_SPIN_CAP) { atomicAdd(&bar[XB_TMO], 1u); break; } }
    }
    nloc = mine > 0u ? mine : 1u; nx = cnt > 0u ? cnt : 1u;
}
__device__ __forceinline__ void xcd_barrier(const XcdBarrier& b, const int tid) {
    asm volatile("s_waitcnt vmcnt(0)" ::: "memory");
    __syncthreads();
    if (tid == 0) {
        unsigned* bar = b.bar;
        __builtin_amdgcn_s_waitcnt(0);
        unsigned nloc = b.st[0], nx = b.st[1];
        if (nloc == 0u) { xcd_barrier_complete(bar, b.x, nloc, nx); b.st[0] = nloc; b.st[1] = nx; }
        const unsigned old = xb_add(&bar[XB_XSUB(b.x)], 1u);
        const unsigned gen = old / nloc;
        if (old + 1u == (gen + 1u) * nloc) {
            __builtin_amdgcn_fence(__ATOMIC_RELEASE, "agent");
            asm volatile("s_waitcnt vmcnt(0)" ::: "memory");
            const unsigned og = xb_add(&bar[XB_TOP], 1u);
            const unsigned tg = og / nx;
            if (og + 1u == (tg + 1u) * nx) xb_add(&bar[XB_TOPGEN], 1u);
            else XB_SPIN(xb_ld(&bar[XB_TOPGEN]) == tg, bar);
            __builtin_amdgcn_fence(__ATOMIC_ACQUIRE, "agent");
            xb_add(&bar[XB_XGEN(b.x)], 1u);
            asm volatile("s_waitcnt vmcnt(0)" ::: "memory");
        } else {
            XB_SPIN(xb_ld(&bar[XB_XGEN(b.x)]) == gen, bar);
            __builtin_amdgcn_fence(__ATOMIC_ACQUIRE, "agent");
            asm volatile("s_waitcnt vmcnt(0)" ::: "memory");
        }
    }
    __syncthreads();
}

__device__ __forceinline__ int lane_id() { int l; asm volatile("v_mbcnt_lo_u32_b32 %0, -1, 0\n\tv_mbcnt_hi_u32_b32 %0, -1, %0" : "=v"(l)); return l; }
__device__ __forceinline__ float wave_sum(float v) {
#pragma unroll
    for (int o = 1; o < 64; o <<= 1) v += __shfl_xor(v, o);
    return v;
}
__device__ __forceinline__ unsigned pk2(float lo, float hi) { return pg8::cvt_pk_bf16(lo, hi); }
__device__ __forceinline__ void unpack8(const u32x4 w, float (&f)[8]) {
#pragma unroll
    for (int e = 0; e < 4; ++e) { f[2 * e] = pg8::bf_lo(w[e]); f[2 * e + 1] = pg8::bf_hi(w[e]); }
}
__device__ __forceinline__ u32x4 pack8f(const float (&f)[8]) { u32x4 w; w.x = pk2(f[0], f[1]); w.y = pk2(f[2], f[3]); w.z = pk2(f[4], f[5]); w.w = pk2(f[6], f[7]); return w; }

struct Args { const float* in[21]; float* out; unsigned char* ws; int ph_lo, ph_hi; };
static_assert(sizeof(Args) == 21 * 8 + 8 + 8 + 8, "Args has no padding");
typedef const __attribute__((address_space(4))) Args* KA;
__device__ __forceinline__ KA launder(KA p) { asm volatile("" : "+s"(p)); return p; }
enum { I_XP = 0, I_XS, I_CK, I_CV, I_C, I_CCTX, I_WMOD, I_BMOD, I_GPREMIX, I_WIN, I_WSCONV, I_SINK, I_WAO, I_WCO, I_WMIX, I_GPOSTMIX, I_GPREFFN, I_WUP, I_WFCONV, I_WDN, I_GPOSTFFN };

__device__ __forceinline__ void p0_mod(KA a, unsigned char* lds_g, int tid, int G) {
    LAS float* sT = (LAS float*)lds_g;
    LAS float* red = (LAS float*)(lds_g + 49152);
    const float* w_mod = a->in[I_WMOD]; const float* b_mod = a->in[I_BMOD]; const float* cv = a->in[I_C]; const float* cctx = a->in[I_CCTX];
    float* mod = (float*)(a->ws + WS_MOD);
    const int cg = tid % 24, rg = tid / 24;
    for (int cbk = blockIdx.x; cbk < 256; cbk += G) {
        f32x4 acc[9];
#pragma unroll
        for (int s = 0; s < 9; ++s) acc[s] = (f32x4){0.f, 0.f, 0.f, 0.f};
        for (int kc = 0; kc < 4; ++kc) {
            __syncthreads();
            for (int idx = tid; idx < 9 * 1024; idx += NWAVES * 64) { const int s = idx >> 10, k = idx & 1023;
                const float c = (s == 0) ? cctx[kc * 1024 + k] : cv[(s - 1) * DM + kc * 1024 + k];
                sT[k * 12 + s] = c / (1.f + expf(-c)); }
            __syncthreads();
            if (tid < 504) {
                const float* wp = w_mod + (size_t)(kc * 1024) * 24576 + cbk * 96 + cg * 4;
#pragma unroll 4
                for (int kk = rg; kk < 1024; kk += 21) {
                    const f32x4 w = __builtin_nontemporal_load((const f32x4*)(wp + (size_t)kk * 24576));
                    const f32x4 s0 = *(const LAS f32x4*)(sT + kk * 12), s1 = *(const LAS f32x4*)(sT + kk * 12 + 4), s2 = *(const LAS f32x4*)(sT + kk * 12 + 8);
                    acc[0] += w * s0.x; acc[1] += w * s0.y; acc[2] += w * s0.z; acc[3] += w * s0.w;
                    acc[4] += w * s1.x; acc[5] += w * s1.y; acc[6] += w * s1.z; acc[7] += w * s1.w; acc[8] += w * s2.x;
                }
            }
        }
        if (tid < 504) {
#pragma unroll
            for (int s = 0; s < 9; ++s) *(LAS f32x4*)(red + (rg * 9 + s) * 96 + cg * 4) = acc[s];
        }
        __syncthreads();
        for (int o = tid; o < 9 * 96; o += NWAVES * 64) { const int s = o / 96, cc = o % 96; float sum = 0.f;
            for (int r2 = 0; r2 < 21; ++r2) sum += red[(r2 * 9 + s) * 96 + cc];
            const int col = cbk * 96 + cc, mi = col >> 12, c = col & 4095; float v = sum + b_mod[col];
            if (mi == 1) v = a->in[I_GPREMIX][c] * (1.f + v); else if (mi == 2) v *= a->in[I_GPOSTMIX][c]; else if (mi == 4) v = a->in[I_GPREFFN][c] * (1.f + v); else if (mi == 5) v *= a->in[I_GPOSTFFN][c];
            mod[(size_t)s * 24576 + col] = v; }
        __syncthreads();
    }
}
__device__ __forceinline__ int cvt_rowmap(int n, int rowmap) {
    if (rowmap == 1) { int r = n; if (n < 5120) { const int d = n & 127; r = (n & ~127) | ((d & 64) | ((d & 16) << 1) | ((d & 8) << 1) | ((d & 4) << 1) | ((d & 32) >> 3) | (d & 3)); }
        return r - 4096; }
    return n;
}
__device__ __forceinline__ int wup8_row(int n) { const int isv = n >= DFF, ch = isv ? n - DFF : n; return (ch >> 7) * 256 + isv * 128 + (ch & 127); }
__device__ __forceinline__ int w8_row(int n) {
    if (n < 4096) { const int d = n & 127; return (n & ~127) | ((d & 64) | ((d & 16) << 1) | ((d & 8) << 1) | ((d & 4) << 1) | ((d & 32) >> 3) | (d & 3)); }
    return n - 8192;
}
struct CvtItem { const float* W; bf16* dst; int N, ldk, koff, kb, nb, rowmap; };
__device__ __forceinline__ CvtItem cvt_decode(KA a, int it) {
    constexpr int I_IN = 64 * 80, I_AO = 64 * 16, I_CO = 32 * 16, I_MX = 64 * 16, I_UP = 64 * 86;
    CvtItem c; int r = it, nbn; c.koff = 0; c.rowmap = 0;
    if (r < I_IN) { c.W = a->in[I_WIN]; c.N = INW; c.dst = (bf16*)(a->ws + WS_WIN); c.ldk = 4096; nbn = 80; c.rowmap = 1; }
    else if ((r -= I_IN) < I_AO) { c.W = a->in[I_WAO]; c.N = 4096; c.dst = (bf16*)(a->ws + WS_WCAT); c.ldk = 2048; nbn = 16; c.rowmap = 3; }
    else if ((r -= I_AO) < I_CO) { c.W = a->in[I_WCO]; c.N = 4096; c.dst = (bf16*)(a->ws + WS_WCAT); c.ldk = 2048; nbn = 16; }
    else if ((r -= I_CO) < I_MX) { c.W = a->in[I_WMIX]; c.N = 4096; c.dst = (bf16*)(a->ws + WS_WMIX); c.ldk = 4096; nbn = 16; }
    else if ((r -= I_MX) < I_UP) { c.W = a->in[I_WUP]; c.N = UPW; c.dst = (bf16*)(a->ws + WS_WUP8); c.ldk = 4096; nbn = 86; c.rowmap = 2; }
    else { r -= I_UP; c.W = a->in[I_WDN]; c.N = 4096; c.dst = (bf16*)(a->ws + WS_WDN); c.ldk = DFF; nbn = 16; }
    c.kb = r / nbn; c.nb = r % nbn; return c;
}
#define CVT_LOAD(V, C) do { const float* _s = (C).W + (size_t)((C).kb * 64 + wave * 8) * (C).N + (C).nb * 256 + 4 * lane; \
        _Pragma("unroll") for (int j = 0; j < 8; ++j) V[j] = __builtin_nontemporal_load((const f32x4*)(_s + (size_t)j * (C).N)); } while (0)
#define CVT_PUT(V, C, T) do { _Pragma("unroll") for (int i = 0; i < 4; ++i) { u32x4 w; w.x = pk2(V[0][i], V[1][i]); w.y = pk2(V[2][i], V[3][i]); w.z = pk2(V[4][i], V[5][i]); w.w = pk2(V[6][i], V[7][i]); \
            *(LAS u32x4*)((T) + (4 * lane + i) * 144 + wave * 16) = w; } \
        __syncthreads(); \
        _Pragma("unroll") for (int q = 0; q < 4; ++q) { const int idx = q * 512 + tid, row = idx >> 3, ch = idx & 7; \
            const u32x4 w = *(const LAS u32x4*)((T) + row * 144 + ch * 16); \
            u32x4* _d = (u32x4*)((C).dst + (size_t)cvt_rowmap((C).nb * 256 + row, (C).rowmap) * (C).ldk + (C).koff + (C).kb * 64 + ch * 8); \
            if ((C).rowmap != 1) __builtin_nontemporal_store(w, _d); else *_d = w; } } while (0)
#define CVT_AMAX(V, C, T) do { f32x4 _m = (f32x4){0.f, 0.f, 0.f, 0.f}; _Pragma("unroll") for (int j = 0; j < 8; ++j) _m = __builtin_elementwise_max(_m, __builtin_elementwise_abs(V[j])); \
        *(LAS f32x4*)((T) + wave * 1024 + lane * 16) = _m; __syncthreads(); \
        if (tid < 256) { float _x = 0.f; _Pragma("unroll") for (int w_ = 0; w_ < 8; ++w_) _x = fmaxf(_x, *(const LAS float*)((T) + w_ * 1024 + tid * 4)); \
            atomicMax((unsigned*)(a->ws + WS_CTL) + ((C).rowmap == 1 ? CW_CMAX + w8_row((C).nb * 256 + tid) : (C).rowmap == 2 ? CW_CMAX2 + wup8_row((C).nb * 256 + tid) : CW_CMAX3 + (C).nb * 256 + tid), __float_as_uint(_x)); } } while (0)
#define CVT_ITEM(V, C, T) do { if (((C).rowmap == 1 && ((C).nb < 16 || (C).nb >= 48)) || (C).rowmap == 2 || (C).rowmap == 3) CVT_AMAX(V, C, T); else CVT_PUT(V, C, T); } while (0)
__device__ __forceinline__ void p0_convert(KA a, int vcu, int G, int wave, int lane, int tid, int gtid, int NGT, LAS unsigned char* L) {
    constexpr int NIT = 64 * 80 + 64 * 16 + 32 * 16 + 64 * 16 + 64 * 86 + 172 * 16;
    { f32x4 va[8], vb[8]; CvtItem ca, cb; int it = vcu; LAS unsigned char* T0 = L; LAS unsigned char* T1 = L + 36864;
      __syncthreads();
      if (it < NIT) { ca = cvt_decode(a, it); CVT_LOAD(va, ca); }
      for (; it < NIT; it += 2 * G) {
          const int i2 = it + G, i3 = it + 2 * G;
          if (i2 < NIT) { cb = cvt_decode(a, i2); CVT_LOAD(vb, cb); }
          CVT_ITEM(va, ca, T0);
          if (i3 < NIT) { ca = cvt_decode(a, i3); CVT_LOAD(va, ca); }
          if (i2 < NIT) CVT_ITEM(vb, cb, T1);
      }
      __syncthreads(); }
    { const float* ck = a->in[I_CK]; const float* cvv = a->in[I_CV]; bf16* ckb = (bf16*)(a->ws + WS_CK); bf16* cvb = (bf16*)(a->ws + WS_CV);
      constexpr int NCH = 8 * PAST * KVW / 8;
      for (int i = gtid; i < 2 * NCH; i += NGT) {
          const bool isk = i < NCH; const int j = isk ? i : i - NCH; const float* s = (isk ? ck : cvv) + (size_t)j * 8;
          const f32x4 x0 = *(const f32x4*)s, x1 = *(const f32x4*)(s + 4);
          if (isk) { const int d = (j * 8) & 127; const size_t rowb = (size_t)(j * 8) & ~(size_t)127;
              const int p = (d & 64) | ((d & 16) << 1) | ((d & 8) << 1) | ((d & 32) >> 3);
              u32x2 w0, w1; w0.x = pk2(x0[0], x0[1]); w0.y = pk2(x0[2], x0[3]); w1.x = pk2(x1[0], x1[1]); w1.y = pk2(x1[2], x1[3]);
              *(u32x2*)(ckb + rowb + p) = w0; *(u32x2*)(ckb + rowb + p + 8) = w1; }
          else { u32x4 w; w.x = pk2(x0[0], x0[1]); w.y = pk2(x0[2], x0[3]); w.z = pk2(x1[0], x1[1]); w.w = pk2(x1[2], x1[3]); *(u32x4*)(cvb + (size_t)j * 8) = w; }
      } }
    { float* rc = (float*)(a->ws + WS_ROPE); float* rs = rc + 2048 * 64;
      for (int i = gtid; i < 2048 * 64; i += NGT) { const int pos = i >> 6, af = i & 63, axis = af >> 5, f = af & 31;
          const float inv = (float)pow(10000.0, -(double)f / 32.0); const float p = (float)(axis ? (pos & 63) : (pos >> 6)); const float ang = p * inv;
          rc[i] = (float)cos((double)ang); rs[i] = (float)sin((double)ang); } }
}
__device__ __forceinline__ const float* x_row(KA a, int row) { return row < NCTX ? a->in[I_XP] + (size_t)row * DM : a->in[I_XS] + (size_t)(row - NCTX) * DM; }
__device__ __forceinline__ int set_of(int row) { return row < NCTX ? 0 : 1 + ((row - NCTX) >> 11); }
template <int NV> __device__ __forceinline__ void fill_mod_lds(KA a, LAS float* L, int setLo, int setHi, const int (&vi)[NV], int tid) {
    const float* mod = (const float*)(a->ws + WS_MOD);
    for (int idx = tid; idx < 2 * NV * 1024; idx += NWAVES * 64) { const int bank = idx / (NV * 1024), v = (idx / 1024) % NV, c4 = idx & 1023;
        *(LAS f32x4*)(L + (size_t)((bank * NV + v) * 4096 + 4 * c4)) = *(const f32x4*)(mod + (size_t)(bank ? setHi : setLo) * 24576 + vi[v] * DM + 4 * c4); }
    __syncthreads();
}
#define LOADX(X, r) do { const float* _p = x_row(a, (r)) + 8 * lane; _Pragma("unroll") for (int j = 0; j < 8; ++j) { X[j][0] = __builtin_nontemporal_load((const f32x4*)(_p + 512 * j)); X[j][1] = __builtin_nontemporal_load((const f32x4*)(_p + 512 * j + 4)); } } while (0)
#define LOADY(Y, base, r) do { const bf16* _p = (base) + (size_t)(r) * DM + 8 * lane; _Pragma("unroll") for (int j = 0; j < 8; ++j) Y[j] = *(const u32x4*)(_p + 512 * j); } while (0)
#define LOADO(X, r) do { const float* _p = a->out + (size_t)(r) * DM + 8 * lane; _Pragma("unroll") for (int j = 0; j < 8; ++j) { X[j][0] = *(const f32x4*)(_p + 512 * j); X[j][1] = *(const f32x4*)(_p + 512 * j + 4); } } while (0)
__device__ __forceinline__ float ssq_x(const f32x4 (&x)[8][2]) { float ss = 0.f;
#pragma unroll
    for (int j = 0; j < 8; ++j)
#pragma unroll
        for (int h = 0; h < 2; ++h) ss += (x[j][h][0] * x[j][h][0] + x[j][h][1] * x[j][h][1]) + (x[j][h][2] * x[j][h][2] + x[j][h][3] * x[j][h][3]);
    return ss; }
__device__ __forceinline__ float ssq_y(const u32x4 (&yp)[8]) { float ss = 0.f;
#pragma unroll
    for (int j = 0; j < 8; ++j) { float y[8]; unpack8(yp[j], y);
#pragma unroll
        for (int e = 0; e < 8; ++e) ss += y[e] * y[e]; }
    return ss; }
__device__ __forceinline__ void p1_row(KA a, f32x4 (&x)[8][2], int row, const LAS float* L, int setLo, int lane) {
    const float rstd = rsqrtf(wave_sum(ssq_x(x)) * (1.f / DM) + EPS);
    const LAS float* Lb = L + (set_of(row) == setLo ? 0 : 2 * 4096) + 8 * lane; bf16* hrow = (bf16*)(a->ws + WS_H) + (size_t)row * DM + 8 * lane;
    float amax = 0.f;
#pragma unroll
    for (int j = 0; j < 8; ++j) {
#pragma unroll
        for (int h = 0; h < 2; ++h) { const int c = 512 * j + 4 * h; x[j][h] = (x[j][h] * rstd) * *(const LAS f32x4*)(Lb + c) + *(const LAS f32x4*)(Lb + 4096 + c);
            const f32x4 ab = __builtin_elementwise_abs(x[j][h]); amax = fmaxf(amax, fmaxf(fmaxf(ab[0], ab[1]), fmaxf(ab[2], ab[3]))); }
        *(u32x4*)(hrow + 512 * j) = pg8::pack8(x[j][0], x[j][1]); }
#pragma unroll
    for (int o = 1; o < 64; o <<= 1) amax = fmaxf(amax, __shfl_xor(amax, o));
    const float sa = amax > 0.f ? amax * (1.f / 127.f) : 1.f, inv = 1.f / sa;
    if (lane == 0) ((float*)(a->ws + WS_SA))[row] = sa;
    signed char* qrow = (signed char*)(a->ws + WS_H8) + (size_t)row * DM + 8 * lane;
#pragma unroll
    for (int j = 0; j < 8; ++j) { unsigned w[2];
#pragma unroll
        for (int h = 0; h < 2; ++h) { const f32x4 q = x[j][h] * inv;
            const int q0 = (int)rintf(q[0]), q1 = (int)rintf(q[1]), q2 = (int)rintf(q[2]), q3 = (int)rintf(q[3]);
            w[h] = (unsigned)(q0 & 255) | ((unsigned)(q1 & 255) << 8) | ((unsigned)(q2 & 255) << 16) | ((unsigned)(q3 & 255) << 24); }
        u32x2 pw; pw.x = w[0]; pw.y = w[1]; *(u32x2*)(qrow + 512 * j) = pw; }
}
template <int WHICH> __device__ __forceinline__ void p1_w8(KA a, int vcu, int G, int wave, int lane, int tid, LAS unsigned char* T) {
    constexpr int NBN = WHICH == 0 ? 48 : WHICH == 1 ? 86 : 16, N = WHICH == 0 ? INW : WHICH == 1 ? UPW : DM;
    const float* W = a->in[WHICH == 0 ? I_WIN : WHICH == 1 ? I_WUP : I_WAO]; const unsigned* cmax = (const unsigned*)(a->ws + WS_CTL) + (WHICH == 0 ? CW_CMAX : WHICH == 1 ? CW_CMAX2 : CW_CMAX3);
    signed char* W8 = (signed char*)(a->ws + (WHICH == 0 ? WS_W8 : WHICH == 1 ? WS_WUP8 : WS_WA8)); float* SB = (float*)(a->ws + (WHICH == 0 ? WS_SB : WHICH == 1 ? WS_SB2 : WS_SB3));
#define W8ROW(n_) (WHICH == 0 ? w8_row(n_) : WHICH == 1 ? wup8_row(n_) : (n_))
    for (int it = vcu; it < 32 * NBN; it += G) {
        const int kb = it / NBN, nq = it % NBN, nb = WHICH == 0 ? (nq < 16 ? nq : nq + 32) : nq;
        const int n = nb * 256 + 4 * lane;
        const float* src = W + (size_t)(kb * 128 + wave * 16) * N + n;
        f32x4 v[16];
#pragma unroll
        for (int j = 0; j < 16; ++j) v[j] = __builtin_nontemporal_load((const f32x4*)(src + (size_t)j * N));
        f32x4 inv;
#pragma unroll
        for (int i = 0; i < 4; ++i) { const float m = __uint_as_float(cmax[W8ROW(n + i)]); inv[i] = m > 0.f ? 127.f / m : 0.f; }
        __syncthreads();
#pragma unroll
        for (int i = 0; i < 4; ++i) { u32x4 w;
#pragma unroll
            for (int d = 0; d < 4; ++d) { unsigned x = 0;
#pragma unroll
                for (int e = 0; e < 4; ++e) { const int q = (int)rintf(v[4 * d + e][i] * inv[i]); x |= (unsigned)(q & 255) << (8 * e); }
                w[d] = x; }
            *(LAS u32x4*)(T + (4 * lane + i) * 144 + wave * 16) = w; }
        __syncthreads();
#pragma unroll
        for (int q = 0; q < 4; ++q) { const int idx = q * 512 + tid, row = idx >> 3, ch = idx & 7;
            const u32x4 w = *(const LAS u32x4*)(T + row * 144 + ch * 16);
            *(u32x4*)(W8 + (size_t)W8ROW(nb * 256 + row) * 4096 + kb * 128 + ch * 16) = w; }
        if (kb == 0 && tid < 256) { const float m = __uint_as_float(cmax[W8ROW(nb * 256 + tid)]); SB[W8ROW(nb * 256 + tid)] = m > 0.f ? m * (1.f / 127.f) : 1.f; }
    }
    __syncthreads();
#undef W8ROW
}
__device__ __forceinline__ void p1_h1(KA a, unsigned char* lds_g, int vcu, int G, int wave, int lane, int tid) {
    LAS float* L = (LAS float*)lds_g;
    const int nrb = (MTOT + G - 1) / G, base = vcu * nrb, lim = (base + nrb) < MTOT ? (base + nrb) : MTOT;
    if (base < MTOT) {
        const int setLo = set_of(base); { const int vi[2] = {1, 0}; fill_mod_lds<2>(a, L, setLo, set_of(lim - 1), vi, tid); }
        f32x4 xa[8][2], xb[8][2];
        int row = base + wave;
        if (row < lim) LOADX(xa, row);
        for (; row < lim; row += 2 * NWAVES) {
            const int r2 = row + NWAVES, r3 = row + 2 * NWAVES;
            if (r2 < lim) LOADX(xb, r2);
            p1_row(a, xa, row, L, setLo, lane);
            if (r3 < lim) LOADX(xa, r3);
            if (r2 < lim) p1_row(a, xb, r2, L, setLo, lane);
        }
    }
    p1_w8<0>(a, vcu, G, wave, lane, tid, (LAS unsigned char*)lds_g + 65536);
    p1_w8<1>(a, vcu, G, wave, lane, tid, (LAS unsigned char*)lds_g + 65536);
    p1_w8<2>(a, vcu, G, wave, lane, tid, (LAS unsigned char*)lds_g + 65536);
}
__device__ __forceinline__ void p6_row(KA a, const u32x4 (&yp)[8], f32x4 (&x)[8][2], int row, const LAS float* L, int setLo, int lane) {
    const float rstd = rsqrtf(wave_sum(ssq_y(yp)) * (1.f / DM) + EPS);
    const LAS float* Lb = L + (set_of(row) == setLo ? 0 : 3 * 4096) + 8 * lane; float* orow = a->out + (size_t)row * DM + 8 * lane; bf16* hrow = (bf16*)(a->ws + WS_H) + (size_t)row * DM + 8 * lane;
    float ss1 = 0.f;
#pragma unroll
    for (int j = 0; j < 8; ++j) { float y[8]; unpack8(yp[j], y);
#pragma unroll
        for (int h = 0; h < 2; ++h) { const int c = 512 * j + 4 * h; const f32x4 yv = (f32x4){y[4 * h], y[4 * h + 1], y[4 * h + 2], y[4 * h + 3]};
            const f32x4 x1 = x[j][h] + *(const LAS f32x4*)(Lb + c) * (yv * rstd);
            *(f32x4*)(orow + c) = x1; x[j][h] = x1; ss1 += (x1[0] * x1[0] + x1[1] * x1[1]) + (x1[2] * x1[2] + x1[3] * x1[3]); }
        asm volatile("" ::: "memory"); }
    const float rstd1 = rsqrtf(wave_sum(ss1) * (1.f / DM) + EPS);
    float amax = 0.f;
#pragma unroll
    for (int j = 0; j < 8; ++j) {
#pragma unroll
        for (int h = 0; h < 2; ++h) { const int c = 512 * j + 4 * h; x[j][h] = (x[j][h] * rstd1) * *(const LAS f32x4*)(Lb + 4096 + c) + *(const LAS f32x4*)(Lb + 2 * 4096 + c);
            const f32x4 ab = __builtin_elementwise_abs(x[j][h]); amax = fmaxf(amax, fmaxf(fmaxf(ab[0], ab[1]), fmaxf(ab[2], ab[3]))); }
        asm volatile("" ::: "memory"); }
#pragma unroll
    for (int o = 1; o < 64; o <<= 1) amax = fmaxf(amax, __shfl_xor(amax, o));
    const float sa = amax > 0.f ? amax * (1.f / 127.f) : 1.f, inv = 1.f / sa;
    if (lane == 0) ((float*)(a->ws + WS_SA))[row] = sa;
    signed char* qrow = (signed char*)(a->ws + WS_H8) + (size_t)row * DM + 8 * lane;
#pragma unroll
    for (int j = 0; j < 8; ++j) { unsigned w[2];
#pragma unroll
        for (int h = 0; h < 2; ++h) { const f32x4 q = x[j][h] * inv;
            const int q0 = (int)rintf(q[0]), q1 = (int)rintf(q[1]), q2 = (int)rintf(q[2]), q3 = (int)rintf(q[3]);
            w[h] = (unsigned)(q0 & 255) | ((unsigned)(q1 & 255) << 8) | ((unsigned)(q2 & 255) << 16) | ((unsigned)(q3 & 255) << 24); }
        u32x2 pw; pw.x = w[0]; pw.y = w[1]; *(u32x2*)(qrow + 512 * j) = pw; }
}
__device__ __forceinline__ void p6_x1_h2(KA a, unsigned char* lds_g, int vcu, int G, int wave, int lane, int tid) {
    LAS float* L = (LAS float*)lds_g; const bf16* Y = (const bf16*)(a->ws + WS_PROJ);
    const int nrb = (MTOT + G - 1) / G, base = vcu * nrb, lim = (base + nrb) < MTOT ? (base + nrb) : MTOT;
    if (base >= MTOT) return;
    const int setLo = set_of(base); { const int vi[3] = {2, 4, 3}; fill_mod_lds<3>(a, L, setLo, set_of(lim - 1), vi, tid); }
    u32x4 ya[8], yb[8]; f32x4 xa[8][2], xb[8][2];
    const int lane0 = lane;
    for (int row = base + wave; row < lim; row += 2 * NWAVES) {
        const int r2 = row + NWAVES;
        int lane = lane0; asm volatile("" : "+v"(lane));
        LOADY(ya, Y, row); LOADX(xa, row);
        if (r2 < lim) { LOADY(yb, Y, r2); LOADX(xb, r2); }
        p6_row(a, ya, xa, row, L, setLo, lane);
        if (r2 < lim) p6_row(a, yb, xb, r2, L, setLo, lane);
    }
}
#undef LOADX
#undef LOADY
#undef LOADO
constexpr int NR = 2;
__device__ __forceinline__ const float* mod_row(KA a, int row) { return (const float*)(a->ws + WS_MOD) + (size_t)set_of(row) * 24576; }
__device__ __forceinline__ void p10_final(KA a, int gw, int NGW, int lane, const bool dry) {
    const bf16* Fb = (const bf16*)(a->ws + WS_H);
    for (int row0 = gw; row0 < MTOT; row0 += NR * NGW) {
        int row[NR]; bool ok[NR]; u32x4 yp[NR][8]; f32x4 x[NR][8][2]; float rstd[NR];
#pragma unroll
        for (int i = 0; i < NR; ++i) { const int r = row0 + i * NGW; ok[i] = r < MTOT; row[i] = ok[i] ? r : row0;
            const bf16* frow = Fb + (size_t)row[i] * DM + 8 * lane; const float* orow = a->out + (size_t)row[i] * DM + 8 * lane;
#pragma unroll
            for (int j = 0; j < 8; ++j) yp[i][j] = *(const u32x4*)(frow + 512 * j);
#pragma unroll
            for (int j = 0; j < 8; ++j) { x[i][j][0] = *(const f32x4*)(orow + 512 * j); x[i][j][1] = *(const f32x4*)(orow + 512 * j + 4); } }
#pragma unroll
        for (int i = 0; i < NR; ++i) { float ss = 0.f;
#pragma unroll
            for (int j = 0; j < 8; ++j) { float y[8]; unpack8(yp[i][j], y);
#pragma unroll
                for (int e = 0; e < 8; ++e) ss += y[e] * y[e]; }
            rstd[i] = rsqrtf(wave_sum(ss) * (1.f / DM) + EPS); }
#pragma unroll
        for (int i = 0; i < NR; ++i) { const float* md = mod_row(a, row[i]) + 5 * DM + 8 * lane;
            float* orow = (dry ? (float*)(a->ws + WS_F) : a->out) + (size_t)row[i] * DM + 8 * lane;
#pragma unroll
            for (int j = 0; j < 8; ++j) { float y[8]; unpack8(yp[i][j], y);
#pragma unroll
                for (int h = 0; h < 2; ++h) { const int c = 512 * j + 4 * h; const f32x4 m5 = *(const f32x4*)(md + c);
                    const f32x4 yv = (f32x4){y[4 * h], y[4 * h + 1], y[4 * h + 2], y[4 * h + 3]};
                    if (ok[i]) *(f32x4*)(orow + c) = x[i][j][h] + m5 * (yv * rstd[i]); } }
        }
    }
}
__device__ __forceinline__ void p3_sconv(KA a, int gw, int NGW, int lane, const bool dry) {
    bf16* P = (bf16*)(a->ws + WS_PROJ); const float* w = a->in[I_WSCONV];
    for (int it = gw; it < (MTOT / 8) * 4; it += NGW) {
        const int r0 = (it >> 2) * 8, ch0 = (it & 3) * 512 + 8 * lane;
        const int L = r0 < NCTX ? 256 : 2048, t0 = r0 < NCTX ? (r0 & 255) : ((r0 - NCTX) & 2047);
        bf16* base = P + (size_t)r0 * INW + ch0;
        u32x4 cc[10], ch[10], cb[8];
        const u32x4 z = (u32x4){0u, 0u, 0u, 0u};
        if (t0 > 0) { cc[0] = *(const u32x4*)(base - INW + C_CC); ch[0] = *(const u32x4*)(base - INW + C_CH); } else { cc[0] = z; ch[0] = z; }
#pragma unroll
        for (int i = 0; i < 8; ++i) { cc[i + 1] = *(const u32x4*)(base + (size_t)i * INW + C_CC); ch[i + 1] = *(const u32x4*)(base + (size_t)i * INW + C_CH); cb[i] = *(const u32x4*)(base + (size_t)i * INW + C_CB); }
        if (t0 + 8 < L) { cc[9] = *(const u32x4*)(base + (size_t)8 * INW + C_CC); ch[9] = *(const u32x4*)(base + (size_t)8 * INW + C_CH); } else { cc[9] = z; ch[9] = z; }
        float w0[8], w1[8], w2[8];
#pragma unroll
        for (int e = 0; e < 8; ++e) { w0[e] = w[ch0 + e]; w1[e] = w[CONVD + ch0 + e]; w2[e] = w[2 * CONVD + ch0 + e]; }
        float prev[8], cur[8], nxt[8], t1[8], t2[8];
        unpack8(cc[0], t1); unpack8(ch[0], t2);
#pragma unroll
        for (int e = 0; e < 8; ++e) prev[e] = t1[e] * t2[e];
        unpack8(cc[1], t1); unpack8(ch[1], t2);
#pragma unroll
        for (int e = 0; e < 8; ++e) cur[e] = t1[e] * t2[e];
#pragma unroll
        for (int i = 0; i < 8; ++i) {
            unpack8(cc[i + 2], t1); unpack8(ch[i + 2], t2);
#pragma unroll
            for (int e = 0; e < 8; ++e) nxt[e] = t1[e] * t2[e];
            float cbf[8], o[8]; unpack8(cb[i], cbf);
#pragma unroll
            for (int e = 0; e < 8; ++e) { o[e] = cbf[e] * (w0[e] * prev[e] + w1[e] * cur[e] + w2[e] * nxt[e]); prev[e] = cur[e]; cur[e] = nxt[e]; }
            if (dry) *(u32x4*)((bf16*)(a->ws + WS_H) + (size_t)(r0 + i) * DM + ch0) = pack8f(o); else *(u32x4*)(base + (size_t)i * INW + C_CB) = pack8f(o);
        }
    }
}
__device__ __forceinline__ void p4_quant_a(KA a, int gw, int NGW, int lane) {
    const bf16* P = (const bf16*)(a->ws + WS_PROJ); signed char* A8 = (signed char*)(a->ws + WS_H8); float* SA = (float*)(a->ws + WS_SA);
    for (int row0 = gw; row0 < MTOT; row0 += 2 * NGW) {
        u32x4 v[2][8]; int row[2]; bool ok[2];
#pragma unroll
        for (int i = 0; i < 2; ++i) { const int r = row0 + i * NGW; ok[i] = r < MTOT; row[i] = ok[i] ? r : row0; const bf16* p = P + (size_t)row[i] * INW + C_Q + 8 * lane;
#pragma unroll
            for (int j = 0; j < 8; ++j) v[i][j] = *(const u32x4*)(p + 512 * j); }
#pragma unroll
        for (int i = 0; i < 2; ++i) { float amax = 0.f;
#pragma unroll
            for (int j = 0; j < 8; ++j) { float f[8]; unpack8(v[i][j], f);
#pragma unroll
                for (int e = 0; e < 8; ++e) amax = fmaxf(amax, fabsf(f[e])); }
#pragma unroll
            for (int o = 1; o < 64; o <<= 1) amax = fmaxf(amax, __shfl_xor(amax, o));
            const float sa = amax > 0.f ? amax * (1.f / 127.f) : 1.f, inv = 1.f / sa;
            if (ok[i]) { if (lane == 0) SA[row[i]] = sa;
#pragma unroll
                for (int j = 0; j < 8; ++j) { float f[8]; unpack8(v[i][j], f); unsigned w[2];
#pragma unroll
                    for (int h = 0; h < 2; ++h) { const int q0 = (int)rintf(f[4 * h] * inv), q1 = (int)rintf(f[4 * h + 1] * inv), q2 = (int)rintf(f[4 * h + 2] * inv), q3 = (int)rintf(f[4 * h + 3] * inv);
                        w[h] = (unsigned)(q0 & 255) | ((unsigned)(q1 & 255) << 8) | ((unsigned)(q2 & 255) << 16) | ((unsigned)(q3 & 255) << 24); }
                    u32x2 pw; pw.x = w[0]; pw.y = w[1]; *(u32x2*)(A8 + (size_t)row[i] * DM + 512 * j + 8 * lane) = pw; } }
        }
    }
}
__device__ __forceinline__ void p8_fixup(KA a, int gtid, int NGT) {
    bf16* Fb = (bf16*)(a->ws + WS_F); const float* w = a->in[I_WFCONV]; const float* sbg = (const float*)(a->ws + WS_SBG); const float* sbv = (const float*)(a->ws + WS_SBV);
    constexpr int NC4 = DFF / 4;
    for (int i = gtid; i < 56 * NC4; i += NGT) {
        const int sidx = i / NC4, c = (i % NC4) * 4; const int T = 32 + (sidx / 7) * 8 + (sidx % 7);
        const f32x4 gA254 = *(const f32x4*)(sbg + ((size_t)T * 4 + 2) * DFF + c), gA255 = *(const f32x4*)(sbg + ((size_t)T * 4 + 3) * DFF + c);
        const f32x4 gB0 = *(const f32x4*)(sbg + ((size_t)(T + 1) * 4 + 0) * DFF + c), gB1 = *(const f32x4*)(sbg + ((size_t)(T + 1) * 4 + 1) * DFF + c);
        const f32x4 vA = *(const f32x4*)(sbv + ((size_t)T * 2 + 1) * DFF + c), vB = *(const f32x4*)(sbv + ((size_t)(T + 1) * 2) * DFF + c);
        const f32x4 w0 = *(const f32x4*)(w + c), w1 = *(const f32x4*)(w + DFF + c), w2 = *(const f32x4*)(w + 2 * DFF + c);
        const f32x4 ca = w0 * gA254 + w1 * gA255 + w2 * gB0, cb = w0 * gA255 + w1 * gB0 + w2 * gB1;
        f32x4 oa, ob;
#pragma unroll
        for (int j = 0; j < 4; ++j) { oa[j] = ca[j] * __builtin_amdgcn_rcpf(1.f + __expf(-ca[j])) * vA[j]; ob[j] = cb[j] * __builtin_amdgcn_rcpf(1.f + __expf(-cb[j])) * vB[j]; }
        u32x2 pa, pb; pa.x = pk2(oa[0], oa[1]); pa.y = pk2(oa[2], oa[3]); pb.x = pk2(ob[0], ob[1]); pb.y = pk2(ob[2], ob[3]);
        *(u32x2*)(Fb + ((size_t)T * 256 + 255) * DFF + c) = pa; *(u32x2*)(Fb + ((size_t)(T + 1) * 256) * DFF + c) = pb;
    }
}
__device__ __forceinline__ void p3_attention(KA a, char* lds, int vcu, int G, int tid, const bool dry) {
    bf16* P = (bf16*)(a->ws + WS_PROJ); const bf16* CKb = (const bf16*)(a->ws + WS_CK); const bf16* CVb = (const bf16*)(a->ws + WS_CV); const float* sinkp = a->in[I_SINK];
    const int wid = tid >> 6, lane = tid & 63, r32 = lane & 31, hi = lane >> 5;
    const int perL = (2048 + G - 1) / G, perC = (1024 + G - 1) / G;
    for (int i = 0; i < perL + perC; ++i) {
        const bool lat = i < perL;
        const int id = lat ? vcu * perL + i : vcu * perC + (i - perL);
        if (id >= (lat ? 2048 : 1024)) continue;
        att::Src S; int rowbase, kvh, hp, qb;
        if (lat) { hp = id & 1; qb = (id >> 1) & 15; kvh = (id >> 5) & 7; const int b = id >> 8; rowbase = NCTX + b * 2048;
            const int kb_lo = qb > 0 ? qb - 1 : 0, kb_hi = qb < 15 ? qb + 1 : 15;
            S.nA = 8; S.KA = CKb + (size_t)b * PAST * KVW + kvh * 128; S.VA = CVb + (size_t)b * PAST * KVW + kvh * 128;
            S.nB = (kb_hi - kb_lo + 1) * 2; S.kpos0 = kb_lo * 128; S.masked = 1; }
        else { hp = id & 1; qb = (id >> 1) & 1; kvh = (id >> 2) & 7; const int b = id >> 5; rowbase = b * 256;
            S.nA = 0; S.KA = CKb; S.VA = CVb; S.nB = 4; S.kpos0 = 0; S.masked = 0; }
        S.qpos0 = qb * 128;
        S.KB = P + (size_t)(rowbase + S.kpos0) * INW + C_K + kvh * 128; S.VB = P + (size_t)(rowbase + S.kpos0) * INW + C_V + kvh * 128;
        const int head = kvh * 4 + hp * 2 + (wid >> 2);
        const size_t qrow0 = (size_t)rowbase + qb * 128 + 32 * (wid & 3);
        bf16* Ow = dry ? (bf16*)(a->ws + WS_H) + qrow0 * DM + head * 128 : P + qrow0 * INW + C_Q + head * 128;
        att::attn_unit(P + (qrow0 + r32) * INW + C_Q + head * 128 + hi * 8, Ow, S, sinkp[head], lds, tid, dry ? DM : INW);
    }
}

__global__ void __launch_bounds__(NWAVES * 64, 2) mk_fwd(Args args_) {
    const KA kp = (KA)__builtin_amdgcn_kernarg_segment_ptr(); (void)args_;
#define args (launder(kp))
    extern __shared__ __attribute__((aligned(16))) unsigned char lds[];
    const int wave = __builtin_amdgcn_readfirstlane((int)threadIdx.x >> 6);
#define LANE_TID() const int lane = lane_id(); const int tid = wave * 64 + lane; (void)tid; (void)lane
    const int G = gridDim.x; const int bx = blockIdx.x; const int vcu = (G % 8 == 0) ? (bx % 8) * (G / 8) + bx / 8 : bx;
    const int gw = vcu * NWAVES + wave, NGW = G * NWAVES;
    LAS unsigned char* ldsl = (LAS unsigned char*)lds;
    volatile LAS unsigned* MISC = (volatile LAS unsigned*)(ldsl + MISC_OFF);
    { LANE_TID(); for (int u = tid; u < (LDS_BYTES - RING_BYTES) / 4; u += NWAVES * 64) ((LAS unsigned*)(ldsl + RING_BYTES))[u] = 0u; }
    __syncthreads();
    unsigned* ctl = (unsigned*)(args->ws + WS_CTL);
    XcdBarrier bar; bar.bar = ctl + CW_BAR; bar.x = 0; bar.st = nullptr;
    if (N_LAUNCHES == 1) { LANE_TID(); bar = xcd_barrier_post(ctl + CW_BAR, MISC + 8, tid); }
    const int lo = args->ph_lo, hi = args->ph_hi;
#ifndef PHASE_MASK
#define PHASE_MASK 0x7ff
#endif
#define IN(k) ((((PHASE_MASK) >> (k)) & 1) && lo <= (k) && (k) < hi)
#ifndef REPEAT_MASK
#define REPEAT_MASK 0
#endif
#ifndef PROBE_P0
#define PROBE_P0 0
#endif
#ifndef PROBE_DRY
#define PROBE_DRY 0
#endif
#define REPS(k) (1 + ((((REPEAT_MASK) | (PROBE_DRY)) >> (k)) & 1))
#define SEAM(k) do { if (IN(k) && IN((k) + 1)) { LANE_TID(); xcd_barrier(bar, tid); } } while (0)
#define Hb ((bf16*)(args->ws + WS_H))
#define Pb ((bf16*)(args->ws + WS_PROJ))
#define Fb ((bf16*)(args->ws + WS_F))

    if (IN(0)) for (int rep_ = 0; rep_ < REPS(0); ++rep_) { LANE_TID();
        for (int r2 = 0; r2 < 1 + (PROBE_P0 & 1); ++r2) p0_mod(args, lds, tid, G);
        for (int r2 = 0; r2 < 1 + (PROBE_P0 >> 1 & 1); ++r2) p0_convert(args, vcu, G, wave, lane, tid, gw * 64 + lane, NGW * 64, ldsl); }
    SEAM(0);
    if (IN(1)) for (int rep_ = 0; rep_ < REPS(1); ++rep_) { LANE_TID(); p1_h1(args, lds, vcu, G, wave, lane, tid); }
    SEAM(1);
    if (IN(2)) for (int rep_ = 0; rep_ < REPS(2); ++rep_) {
        LANE_TID();
        { pg8::Gemm g{Hb, (const bf16*)(args->ws + WS_WIN), MTOT, 8192, DM, DM, 1 << 30, 0}; pg8::GroupOrder S; S.init(MTOT, 8192, G, vcu); S.off0 = 16;
          pg8::EpiIn E{Pb, args->out + O_NK, args->out + O_NV, (const float*)(args->ws + WS_ROPE), (const float*)(args->ws + WS_ROPE) + 2048 * 64};
          pg8::gemm_phase<pg8::EpiIn, pg8::GroupOrder, true>(ldsl, g, S, E, tid); }
        { pg8::Gemm g{(const bf16*)(args->ws + WS_H8), (const bf16*)(args->ws + WS_W8), MTOT, 12288, DM, DM, 1 << 30, 0}; pg8::GroupOrder S; S.init(MTOT, 12288, G, vcu); S.split = 16; S.off0 = 0; S.off1 = 32;
          pg8::EpiIn8 E{Pb, (const float*)(args->ws + WS_SA), (const float*)(args->ws + WS_SB), (const float*)(args->ws + WS_ROPE), (const float*)(args->ws + WS_ROPE) + 2048 * 64};
          pg8::gemm_phase<pg8::EpiIn8, pg8::GroupOrder, true, true>(ldsl, g, S, E, tid); }
    }
    SEAM(2);
    if (IN(3)) for (int rep_ = 0; rep_ < REPS(3); ++rep_) { LANE_TID(); const bool dry = (PROBE_DRY >> 3 & 1) && rep_ == 0; p3_attention(args, (char*)lds, vcu, G, tid, dry); p3_sconv(args, gw, NGW, lane, dry); }
    SEAM(3);
    if (IN(4)) for (int rep_ = 0; rep_ < REPS(4); ++rep_) {
        LANE_TID();
        p4_quant_a(args, gw, NGW, lane);
        if (lo < hi - 1 || N_LAUNCHES == 1) xcd_barrier(bar, tid);
        { pg8::Gemm g{(const bf16*)(args->ws + WS_H8), (const bf16*)(args->ws + WS_WA8), MTOT, DM, DM, DM, 1 << 30, 0}; pg8::GroupOrder S; S.init(MTOT, DM, G, vcu);
          pg8::EpiT1 E{Pb, Hb, (const float*)(args->ws + WS_SA), (const float*)(args->ws + WS_SB3)};
          pg8::gemm_phase<pg8::EpiT1, pg8::GroupOrder, true, true>(ldsl, g, S, E, tid); }
        { pg8::Gemm g{Pb + C_CB, (const bf16*)(args->ws + WS_WCAT), MTOT, DM, CONVD, INW, 1 << 30, 0}; pg8::GroupOrder S; S.init(MTOT, DM, G, vcu);
          pg8::EpiMerge2 E{Pb, Hb};
          pg8::gemm_phase<pg8::EpiMerge2, pg8::GroupOrder, true>(ldsl, g, S, E, tid); }
    }
    SEAM(4);
    if (IN(5)) for (int rep_ = 0; rep_ < REPS(5); ++rep_) {
        pg8::Gemm g{Hb, (const bf16*)(args->ws + WS_WMIX), MTOT, DM, DM, DM, 1 << 30, 0}; LANE_TID(); pg8::GroupOrder S; S.init(MTOT, DM, G, vcu);
        pg8::EpiStore E{Pb, DM};
        pg8::gemm_phase<pg8::EpiStore, pg8::GroupOrder, true>(ldsl, g, S, E, tid);
    }
    SEAM(5);
    if (IN(6)) for (int rep_ = 0; rep_ < REPS(6); ++rep_) { LANE_TID(); p6_x1_h2(args, lds, vcu, G, wave, lane, tid); }
    SEAM(6);
    if (IN(7)) for (int rep_ = 0; rep_ < REPS(7); ++rep_) {
        LANE_TID();
        pg8::Gemm g{(const bf16*)(args->ws + WS_H8), (const bf16*)(args->ws + WS_WUP8), MTOT, UPW, DM, DM, 1 << 30, 0}; pg8::GroupOrder S; S.init(MTOT, UPW, G, vcu);
        pg8::EpiUp E{Fb, args->in[I_WFCONV], (float*)(args->ws + WS_SBG), (float*)(args->ws + WS_SBV), (LAS float*)(ldsl + RING_BYTES + 1024), (const float*)(args->ws + WS_SA), (const float*)(args->ws + WS_SB2)};
        pg8::gemm_phase<pg8::EpiUp, pg8::GroupOrder, true, true>(ldsl, g, S, E, tid);
    }
    SEAM(7);
    if (IN(8)) for (int rep_ = 0; rep_ < REPS(8); ++rep_) { LANE_TID(); p8_fixup(args, gw * 64 + lane, NGW * 64); }
    SEAM(8);
    if (IN(9)) for (int rep_ = 0; rep_ < REPS(9); ++rep_) {
        pg8::Gemm g{Fb, (const bf16*)(args->ws + WS_WDN), MTOT, DM, DFF, DFF, 1 << 30, 0}; LANE_TID(); pg8::GroupOrder S; S.init(MTOT, DM, G, vcu);
        pg8::EpiStore E{Hb, DM};
        pg8::gemm_phase<pg8::EpiStore, pg8::GroupOrder, true>(ldsl, g, S, E, tid);
    }
    SEAM(9);
    if (IN(10)) for (int rep_ = 0; rep_ < REPS(10); ++rep_) { LANE_TID(); const bool dry = (PROBE_DRY >> 10 & 1) && rep_ == 0; p10_final(args, gw, NGW, lane, dry); }
#undef IN
#undef SEAM
#undef Hb
#undef Pb
#undef Fb
#undef args
}

extern "C" void kernel_launch(void* const* d_in, const int* in_sizes, int n_in, void* d_out, int out_size, void* d_ws, size_t ws_size, hipStream_t stream) {
    static int grid = 0;
    if (grid == 0) {
        if (n_in != 21 || (size_t)out_size != O_END || ws_size < WS_END) { fprintf(stderr, "kernel_launch: shape mismatch (n_in %d out %d ws %zu; need ws >= %zu)\n", n_in, out_size, ws_size, (size_t)WS_END); grid = -1; return; }
        int dev = 0, cus = 0;
        if (hipGetDevice(&dev) != hipSuccess || hipDeviceGetAttribute(&cus, hipDeviceAttributeMultiprocessorCount, dev) != hipSuccess) { grid = -1; return; }
        if (hipFuncSetAttribute((const void*)mk_fwd, hipFuncAttributeMaxDynamicSharedMemorySize, LDS_BYTES) != hipSuccess) { fprintf(stderr, "kernel_launch: hipFuncSetAttribute failed\n"); grid = -1; return; }
        int per_cu = 0;
        if (hipOccupancyMaxActiveBlocksPerMultiprocessor(&per_cu, (const void*)mk_fwd, NWAVES * 64, LDS_BYTES) != hipSuccess || per_cu < 1) fprintf(stderr, "kernel_launch: occupancy query reports %d\n", per_cu);
        (void)hipGetLastError();
        grid = cus;
    }
    if (grid < 0) return;
    (void)hipMemsetAsync((char*)d_ws + WS_CTL, 0, CTL_ZERO_BYTES, stream);
    Args a{};
    for (int i = 0; i < 21; ++i) a.in[i] = (const float*)d_in[i];
    a.out = (float*)d_out; a.ws = (unsigned char*)d_ws;
    for (int li = 0; li < N_LAUNCHES; ++li) {
        a.ph_lo = (N_LAUNCHES == 1) ? 0 : li; a.ph_hi = (N_LAUNCHES == 1) ? N_PHASES : li + 1;
        hipLaunchKernelGGL(mk_fwd, dim3(grid), dim3(NWAVES * 64), LDS_BYTES, stream, a);
    }
}
```

```cpp
#include <hip/hip_runtime.h>
#include <cstdio>
#include <cstdint>

constexpr int DM = 4096, NCTX = 8192, NLAT = 16384, MTOT = 24576;
constexpr int INW = 20480, DFF = 11008, UPW = 22016, KVW = 1024, CONVD = 2048, PAST = 512;
constexpr int C_Q = 0, C_K = 4096, C_V = 5120, C_CB = 6144, C_CC = 8192, C_CH = 10240, C_GA = 12288, C_GC = 16384;
constexpr float EPS = 1e-6f;

namespace pg8 {
#define PG8_LAS __attribute__((address_space(3)))
typedef unsigned short bf16_t;
typedef short bf16x8 __attribute__((ext_vector_type(8)));
typedef float f32x4 __attribute__((ext_vector_type(4)));
typedef unsigned u32x4 __attribute__((ext_vector_type(4)));
typedef int i32x4 __attribute__((ext_vector_type(4)));
constexpr int BM = 256, BK = 64, HALF = 128, HTB = HALF * BK * 2  , STAGE_BYTES = 8 * HTB, NXCD = 8, WGM = 8;

__host__ __device__ __forceinline__ int lds_byte(int r, int c) { const int st = (r >> 4) * 2 + (c >> 5), rr = r & 15, cc = c & 31, ob = rr * 64 + cc * 2; return st * 1024 + (ob ^ (((ob >> 9) & 1) << 5)); }
__host__ __device__ __forceinline__ void stage_rc(int b, int& R, int& C) { const int st = b / 1024, sb = b % 1024, swz = sb ^ (((sb >> 9) & 1) << 5); R = (st >> 1) * 16 + swz / 64; C = (st & 1) * 32 + (swz % 64) / 2; }
__host__ __device__ __forceinline__ int perm32(int rho) { const int n = rho >> 4, i = rho & 15; return 8 * (i >> 2) + 4 * n + (i & 3); }

struct Unit { int pm, pn, pnb; };
struct Gemm { const bf16_t* A; const bf16_t* Bt; int M, N, K, lda, kj_t, kj_bytes; };

struct StaticOrder {
    int nM, nN, nwg, G, c;
    __host__ __device__ void init(int M, int N, int G_, int c_) { nM = M / BM; nN = N / BM; nwg = nM * nN; G = G_; c = c_; }
    __host__ __device__ bool next(int i, Unit& u) const {
        const long L = (long)i * G + c; if (L >= nwg) return false;
        int wgid = (int)L; { const int q = nwg / NXCD, r = nwg % NXCD, xcd = wgid % NXCD, off = wgid / NXCD; wgid = (xcd < r ? xcd * (q + 1) : r * (q + 1) + (xcd - r) * q) + off; }
        const int nig = WGM * nN, gid = wgid / nig, fm = gid * WGM, gsz = (nM - fm) < WGM ? (nM - fm) : WGM;
        u.pm = fm + ((wgid % nig) % gsz); u.pn = (wgid % nig) / gsz; u.pnb = u.pn; return true;
    }
    __device__ __forceinline__ void a_ready(const Unit&) const {}
    __device__ __forceinline__ void done(const Unit&) const {}
};
struct GroupOrder {
    int nM, nN, nwg, G, c, split = 1 << 30, off0 = 0, off1 = 0;
    __host__ __device__ void init(int M, int N, int G_, int c_) { nM = M / BM; nN = N / BM; nwg = nM * nN; G = G_; c = c_; }
    __host__ __device__ bool next(int i, Unit& u) const {
        const long L = (long)i * G + c; if (L >= nwg) return false;
        const int w = (int)L, nig = WGM * nN, gid = w / nig, fm = gid * WGM, gsz = (nM - fm) < WGM ? (nM - fm) : WGM;
        u.pm = fm + ((w % nig) % gsz); u.pnb = (w % nig) / gsz; u.pn = u.pnb + (u.pnb < split ? off0 : off1); return true;
    }
    __device__ __forceinline__ void a_ready(const Unit&) const {}
    __device__ __forceinline__ void done(const Unit&) const {}
};


struct InOrder {
    int G, c; bool i8;
    __device__ __forceinline__ bool next(int i, Unit& u) const {
        const int nc = i8 ? 48 : 32, nl = i8 ? 56 : 24, ctx_total = 4 * 8 * nc, total = ctx_total + 8 * 8 * nl;
        const long L = (long)i * G + c; if (L >= total) return false;
        int w = (int)L, gid, t; bool lat = w >= ctx_total;
        if (!lat) { gid = w / (8 * nc); w %= 8 * nc; } else { w -= ctx_total; gid = 4 + w / (8 * nl); w %= 8 * nl; }
        u.pm = gid * 8 + (w & 7); t = w >> 3;
        if (i8) { if (!lat) { u.pn = t < 16 ? t : t + 32; u.pnb = t < 16 ? t : t + 8; } else { u.pn = t < 24 ? t : t + 24; u.pnb = t; } }
        else { if (!lat) { u.pn = 16 + t; u.pnb = t; } else { u.pn = 24 + t; u.pnb = 8 + t; } }
        return true;
    }
    __device__ __forceinline__ void a_ready(const Unit&) const {}
    __device__ __forceinline__ void done(const Unit&) const {}
};

__device__ __forceinline__ unsigned cvt_pk_bf16(float lo, float hi) { unsigned r; asm volatile("v_cvt_pk_bf16_f32 %0, %1, %2" : "=v"(r) : "v"(lo), "v"(hi)); return r; }
__device__ __forceinline__ float bf_lo(unsigned w) { return __uint_as_float(w << 16); }
__device__ __forceinline__ float bf_hi(unsigned w) { return __uint_as_float(w & 0xffff0000u); }
__device__ __forceinline__ u32x4 pack8(const f32x4 v0, const f32x4 v1) { u32x4 w; w.x = cvt_pk_bf16(v0[0], v0[1]); w.y = cvt_pk_bf16(v0[2], v0[3]); w.z = cvt_pk_bf16(v1[0], v1[1]); w.w = cvt_pk_bf16(v1[2], v1[3]); return w; }

struct EpiStore {
    typedef f32x4 acc_t;
    static constexpr bool PERM = true, HAS_MID = false;
    bf16_t* O; int ldc;
    __device__ __forceinline__ void mid(f32x4 (&)[2][2][4][2], const Unit&, int, int, int, int) const {}
    __device__ __forceinline__ void operator()(const f32x4 (&acc)[2][2][4][2], const Unit& u, int wr, int wc, int fr_, int fq_) const {
        int fr = fr_, fq = fq_; asm volatile("" : "+v"(fr), "+v"(fq));
        const int row0 = u.pm * BM + wr * 64 + fr, col0 = u.pn * BM + wc * 32 + 8 * fq;
#pragma unroll
        for (int ai = 0; ai < 2; ++ai)
#pragma unroll
            for (int m = 0; m < 4; ++m) { bf16_t* rowp = O + (size_t)(row0 + ai * HALF + m * 16) * ldc + col0;
#pragma unroll
                for (int bj = 0; bj < 2; ++bj) *(u32x4*)(rowp + bj * HALF) = pack8(acc[ai][bj][m][0], acc[ai][bj][m][1]); }
    }
};

struct EpiIn {
    typedef f32x4 acc_t;
    static constexpr bool PERM = true, HAS_MID = false;
    bf16_t* P; float* newk; float* newv; const float* rcos; const float* rsin;
    __device__ __forceinline__ void mid(f32x4 (&)[2][2][4][2], const Unit&, int, int, int, int) const {}
    __device__ __forceinline__ void operator()(const f32x4 (&acc)[2][2][4][2], const Unit& u, int wr, int wc, int fr_, int fq_) const {
        int fr = fr_, fq = fq_; asm volatile("" : "+v"(fr), "+v"(fq));
        const int row0 = u.pm * BM + wr * 64 + fr, col0 = u.pn * BM + wc * 32 + 8 * fq;
        const bool rope = (u.pn < 20) && (u.pm >= 32);
        const bool kout = (u.pm < 32) && (u.pn >= 16) && (u.pn < 20);
        const bool vout = (u.pm < 32) && (u.pn >= 20) && (u.pn < 24);
#pragma unroll
        for (int ai = 0; ai < 2; ++ai)
#pragma unroll
            for (int m = 0; m < 4; ++m) {
                const int row = row0 + ai * HALF + m * 16;
                f32x4 cs = (f32x4){1.f, 1.f, 1.f, 1.f}, sn = (f32x4){0.f, 0.f, 0.f, 0.f};
                if (rope) { const int pos = (row - NCTX) & 2047; cs = *(const f32x4*)(rcos + pos * 64 + 16 * wc + 4 * fq); sn = *(const f32x4*)(rsin + pos * 64 + 16 * wc + 4 * fq); }
                bf16_t* rowp = P + (size_t)row * INW + col0;
#pragma unroll
                for (int bj = 0; bj < 2; ++bj) {
                    f32x4 v0 = acc[ai][bj][m][0], v1 = acc[ai][bj][m][1];
                    if (kout) { float* kp = newk + (size_t)row * KVW + (u.pn - 16) * 256 + bj * HALF + 64 * (wc >> 1) + 16 * (wc & 1) + 4 * fq; *(f32x4*)kp = v0; *(f32x4*)(kp + 32) = v1; }
                    if (vout) { float* vp = newv + (size_t)row * KVW + (u.pn - 20) * 256 + bj * HALF + wc * 32 + 8 * fq; *(f32x4*)vp = v0; *(f32x4*)(vp + 4) = v1; }
                    if (rope) { const f32x4 o0 = v0 * cs - v1 * sn, o1 = v0 * sn + v1 * cs; v0 = o0; v1 = o1; }
                    __builtin_nontemporal_store(pack8(v0, v1), (u32x4*)(rowp + bj * HALF));
                }
            }
    }
};


struct EpiIn8 {
    typedef i32x4 acc_t;
    static constexpr bool PERM = true, HAS_MID = false;
    bf16_t* P; const float* sa; const float* sb; const float* rcos; const float* rsin;
    __device__ __forceinline__ void mid(i32x4 (&)[2][2][4][2], const Unit&, int, int, int, int) const {}
    __device__ __forceinline__ void operator()(const i32x4 (&acc)[2][2][4][2], const Unit& u, int wr, int wc, int fr_, int fq_) const {
        int fr = fr_, fq = fq_; asm volatile("" : "+v"(fr), "+v"(fq));
        const int row0 = u.pm * BM + wr * 64 + fr, col0 = u.pn * BM + wc * 32 + 8 * fq, bcol0 = u.pnb * BM + wc * 32 + 8 * fq;
        const bool rope = (u.pn < 20) && (u.pm >= 32);
        f32x4 cb[2][2];
#pragma unroll
        for (int bj = 0; bj < 2; ++bj)
#pragma unroll
            for (int n = 0; n < 2; ++n) cb[bj][n] = *(const f32x4*)(sb + bcol0 + bj * HALF + 4 * n);
#pragma unroll
        for (int ai = 0; ai < 2; ++ai)
#pragma unroll
            for (int m = 0; m < 4; ++m) {
                const int row = row0 + ai * HALF + m * 16; const float ra = sa[row];
                f32x4 cs = (f32x4){1.f, 1.f, 1.f, 1.f}, sn = (f32x4){0.f, 0.f, 0.f, 0.f};
                if (rope) { const int pos = (row - NCTX) & 2047; cs = *(const f32x4*)(rcos + pos * 64 + 16 * wc + 4 * fq); sn = *(const f32x4*)(rsin + pos * 64 + 16 * wc + 4 * fq); }
                bf16_t* rowp = P + (size_t)row * INW + col0;
#pragma unroll
                for (int bj = 0; bj < 2; ++bj) {
                    f32x4 v0 = __builtin_convertvector(acc[ai][bj][m][0], f32x4) * cb[bj][0] * ra, v1 = __builtin_convertvector(acc[ai][bj][m][1], f32x4) * cb[bj][1] * ra;
                    if (rope) { const f32x4 o0 = v0 * cs - v1 * sn, o1 = v0 * sn + v1 * cs; v0 = o0; v1 = o1; }
                    __builtin_nontemporal_store(pack8(v0, v1), (u32x4*)(rowp + bj * HALF));
                }
            }
    }
};

struct EpiMerge {
    typedef f32x4 acc_t;
    static constexpr bool PERM = true, HAS_MID = true;
    const bf16_t* P; bf16_t* O;
    __device__ __forceinline__ void mid(f32x4 (&acc)[2][2][4][2], const Unit& u, int wr, int wc, int fr_, int fq_) const {
        int fr = fr_, fq = fq_; asm volatile("" : "+v"(fr), "+v"(fq));
        const int row0 = u.pm * BM + wr * 64 + fr, col0 = u.pn * BM + wc * 32 + 8 * fq;
#pragma unroll
        for (int ai = 0; ai < 2; ++ai)
#pragma unroll
            for (int m = 0; m < 4; ++m) { const bf16_t* gp = P + (size_t)(row0 + ai * HALF + m * 16) * INW + col0;
#pragma unroll
                for (int bj = 0; bj < 2; ++bj) {
                    const u32x4 ga = *(const u32x4*)(gp + C_GA + bj * HALF), gc = *(const u32x4*)(gp + C_GC + bj * HALF);
#pragma unroll
                    for (int e = 0; e < 4; ++e) {
                        const float a0 = bf_lo(ga[e]), a1 = bf_hi(ga[e]), c0 = bf_lo(gc[e]), c1 = bf_hi(gc[e]);
                        const float r0 = (1.f + __expf(-c0)) * __builtin_amdgcn_rcpf(1.f + __expf(-a0)), r1 = (1.f + __expf(-c1)) * __builtin_amdgcn_rcpf(1.f + __expf(-a1));
                        acc[ai][bj][m][e >> 1][(e & 1) * 2] *= r0; acc[ai][bj][m][e >> 1][(e & 1) * 2 + 1] *= r1;
                    }
                }
                if (m == 3) asm volatile("" ::: "memory");
            }
    }
    __device__ __forceinline__ void operator()(const f32x4 (&acc)[2][2][4][2], const Unit& u, int wr, int wc, int fr_, int fq_) const {
        int fr = fr_, fq = fq_; asm volatile("" : "+v"(fr), "+v"(fq));
        const int row0 = u.pm * BM + wr * 64 + fr, col0 = u.pn * BM + wc * 32 + 8 * fq;
#pragma unroll
        for (int ai = 0; ai < 2; ++ai)
#pragma unroll
            for (int m = 0; m < 4; ++m) { const int row = row0 + ai * HALF + m * 16; const bf16_t* gp = P + (size_t)row * INW + col0 + C_GC; bf16_t* rowp = O + (size_t)row * DM + col0;
#pragma unroll
                for (int bj = 0; bj < 2; ++bj) {
                    const u32x4 gc = *(const u32x4*)(gp + bj * HALF);
                    f32x4 v0 = acc[ai][bj][m][0], v1 = acc[ai][bj][m][1];
                    v0[0] *= __builtin_amdgcn_rcpf(1.f + __expf(-bf_lo(gc[0]))); v0[1] *= __builtin_amdgcn_rcpf(1.f + __expf(-bf_hi(gc[0])));
                    v0[2] *= __builtin_amdgcn_rcpf(1.f + __expf(-bf_lo(gc[1]))); v0[3] *= __builtin_amdgcn_rcpf(1.f + __expf(-bf_hi(gc[1])));
                    v1[0] *= __builtin_amdgcn_rcpf(1.f + __expf(-bf_lo(gc[2]))); v1[1] *= __builtin_amdgcn_rcpf(1.f + __expf(-bf_hi(gc[2])));
                    v1[2] *= __builtin_amdgcn_rcpf(1.f + __expf(-bf_lo(gc[3]))); v1[3] *= __builtin_amdgcn_rcpf(1.f + __expf(-bf_hi(gc[3])));
                    *(u32x4*)(rowp + bj * HALF) = pack8(v0, v1);
                }
            }
    }
};


struct EpiT1 {
    typedef i32x4 acc_t;
    static constexpr bool PERM = true, HAS_MID = false;
    const bf16_t* P; bf16_t* O; const float* sa; const float* sb;
    __device__ __forceinline__ void mid(i32x4 (&)[2][2][4][2], const Unit&, int, int, int, int) const {}
    __device__ __forceinline__ void operator()(const i32x4 (&acc)[2][2][4][2], const Unit& u, int wr, int wc, int fr_, int fq_) const {
        int fr = fr_, fq = fq_; asm volatile("" : "+v"(fr), "+v"(fq));
        const int row0 = u.pm * BM + wr * 64 + fr, col0 = u.pn * BM + wc * 32 + 8 * fq;
        f32x4 cb[2][2];
#pragma unroll
        for (int bj = 0; bj < 2; ++bj)
#pragma unroll
            for (int n = 0; n < 2; ++n) cb[bj][n] = *(const f32x4*)(sb + col0 + bj * HALF + 4 * n);
#pragma unroll
        for (int ai = 0; ai < 2; ++ai)
#pragma unroll
            for (int m = 0; m < 4; ++m) { const int row = row0 + ai * HALF + m * 16; const float ra = sa[row]; const bf16_t* gp = P + (size_t)row * INW + col0 + C_GA; bf16_t* rowp = O + (size_t)row * DM + col0;
#pragma unroll
                for (int bj = 0; bj < 2; ++bj) {
                    const u32x4 ga = __builtin_nontemporal_load((const u32x4*)(gp + bj * HALF));
                    f32x4 v0 = __builtin_convertvector(acc[ai][bj][m][0], f32x4) * cb[bj][0] * ra, v1 = __builtin_convertvector(acc[ai][bj][m][1], f32x4) * cb[bj][1] * ra;
                    v0[0] *= __builtin_amdgcn_rcpf(1.f + __expf(-bf_lo(ga[0]))); v0[1] *= __builtin_amdgcn_rcpf(1.f + __expf(-bf_hi(ga[0])));
                    v0[2] *= __builtin_amdgcn_rcpf(1.f + __expf(-bf_lo(ga[1]))); v0[3] *= __builtin_amdgcn_rcpf(1.f + __expf(-bf_hi(ga[1])));
                    v1[0] *= __builtin_amdgcn_rcpf(1.f + __expf(-bf_lo(ga[2]))); v1[1] *= __builtin_amdgcn_rcpf(1.f + __expf(-bf_hi(ga[2])));
                    v1[2] *= __builtin_amdgcn_rcpf(1.f + __expf(-bf_lo(ga[3]))); v1[3] *= __builtin_amdgcn_rcpf(1.f + __expf(-bf_hi(ga[3])));
                    *(u32x4*)(rowp + bj * HALF) = pack8(v0, v1);
                }
            }
    }
};
struct EpiMerge2 {
    typedef f32x4 acc_t;
    static constexpr bool PERM = true, HAS_MID = false;
    const bf16_t* P; bf16_t* O;
    __device__ __forceinline__ void mid(f32x4 (&)[2][2][4][2], const Unit&, int, int, int, int) const {}
    __device__ __forceinline__ void operator()(const f32x4 (&acc)[2][2][4][2], const Unit& u, int wr, int wc, int fr_, int fq_) const {
        int fr = fr_, fq = fq_; asm volatile("" : "+v"(fr), "+v"(fq));
        const int row0 = u.pm * BM + wr * 64 + fr, col0 = u.pn * BM + wc * 32 + 8 * fq;
#pragma unroll
        for (int ai = 0; ai < 2; ++ai)
#pragma unroll
            for (int m = 0; m < 4; ++m) { const int row = row0 + ai * HALF + m * 16; const bf16_t* gp = P + (size_t)row * INW + col0 + C_GC; bf16_t* rowp = O + (size_t)row * DM + col0;
#pragma unroll
                for (int bj = 0; bj < 2; ++bj) {
                    const u32x4 gc = __builtin_nontemporal_load((const u32x4*)(gp + bj * HALF)), tp = *(const u32x4*)(rowp + bj * HALF);
                    f32x4 v0 = acc[ai][bj][m][0], v1 = acc[ai][bj][m][1];
                    v0[0] = bf_lo(tp[0]) + v0[0] * __builtin_amdgcn_rcpf(1.f + __expf(-bf_lo(gc[0]))); v0[1] = bf_hi(tp[0]) + v0[1] * __builtin_amdgcn_rcpf(1.f + __expf(-bf_hi(gc[0])));
                    v0[2] = bf_lo(tp[1]) + v0[2] * __builtin_amdgcn_rcpf(1.f + __expf(-bf_lo(gc[1]))); v0[3] = bf_hi(tp[1]) + v0[3] * __builtin_amdgcn_rcpf(1.f + __expf(-bf_hi(gc[1])));
                    v1[0] = bf_lo(tp[2]) + v1[0] * __builtin_amdgcn_rcpf(1.f + __expf(-bf_lo(gc[2]))); v1[1] = bf_hi(tp[2]) + v1[1] * __builtin_amdgcn_rcpf(1.f + __expf(-bf_hi(gc[2])));
                    v1[2] = bf_lo(tp[3]) + v1[2] * __builtin_amdgcn_rcpf(1.f + __expf(-bf_lo(gc[3]))); v1[3] = bf_hi(tp[3]) + v1[3] * __builtin_amdgcn_rcpf(1.f + __expf(-bf_hi(gc[3])));
                    *(u32x4*)(rowp + bj * HALF) = pack8(v0, v1);
                }
            }
    }
};

struct EpiUp {
    typedef i32x4 acc_t;
    static constexpr bool PERM = true, HAS_MID = false;
    bf16_t* F; const float* wconv; float* sbg; float* sbv; PG8_LAS float* halo; const float* sa; const float* sb;
    __device__ __forceinline__ void mid(i32x4 (&)[2][2][4][2], const Unit&, int, int, int, int) const {}
    __device__ __forceinline__ void operator()(const i32x4 (&acc)[2][2][4][2], const Unit& u, int wr, int wc, int fr_, int fq_) const {
        int fr = fr_, fq = fq_; asm volatile("" : "+v"(fr), "+v"(fq));
        const int colh = wc * 32 + 8 * fq, ch0 = u.pn * 128 + colh;
        f32x4 g[2][4][2], v[2][4][2];
        { f32x4 cg[2], cv[2];
#pragma unroll
          for (int n = 0; n < 2; ++n) { cg[n] = *(const f32x4*)(sb + u.pn * 256 + colh + 4 * n); cv[n] = *(const f32x4*)(sb + u.pn * 256 + HALF + colh + 4 * n); }
#pragma unroll
          for (int ai = 0; ai < 2; ++ai)
#pragma unroll
              for (int m = 0; m < 4; ++m) { const float ra = sa[u.pm * BM + ai * HALF + wr * 64 + m * 16 + fr];
#pragma unroll
                  for (int n = 0; n < 2; ++n) { g[ai][m][n] = __builtin_convertvector(acc[ai][0][m][n], f32x4) * cg[n] * ra; v[ai][m][n] = __builtin_convertvector(acc[ai][1][m][n], f32x4) * cv[n] * ra; } } }
#pragma unroll
        for (int ai = 0; ai < 2; ++ai) { const int sp = 2 * ai + wr;
            if (fr == 0)  { *(PG8_LAS f32x4*)(halo + (0 * 4 + sp) * 128 + colh) = g[ai][0][0]; *(PG8_LAS f32x4*)(halo + (0 * 4 + sp) * 128 + colh + 4) = g[ai][0][1]; }
            if (fr == 15) { *(PG8_LAS f32x4*)(halo + (1 * 4 + sp) * 128 + colh) = g[ai][3][0]; *(PG8_LAS f32x4*)(halo + (1 * 4 + sp) * 128 + colh + 4) = g[ai][3][1]; } }
        asm volatile("s_waitcnt lgkmcnt(0)" ::: "memory"); __builtin_amdgcn_s_barrier(); asm volatile("" ::: "memory");
        if (u.pm >= 32) {
            if (wr == 0 && fr < 2) { float* p = sbg + ((size_t)u.pm * 4 + fr) * DFF + ch0; *(f32x4*)p = g[0][0][0]; *(f32x4*)(p + 4) = g[0][0][1];
                if (fr == 0) { float* q = sbv + ((size_t)u.pm * 2) * DFF + ch0; *(f32x4*)q = v[0][0][0]; *(f32x4*)(q + 4) = v[0][0][1]; } }
            if (wr == 1 && fr >= 14) { float* p = sbg + ((size_t)u.pm * 4 + 2 + (fr - 14)) * DFF + ch0; *(f32x4*)p = g[1][3][0]; *(f32x4*)(p + 4) = g[1][3][1];
                if (fr == 15) { float* q = sbv + ((size_t)u.pm * 2 + 1) * DFF + ch0; *(f32x4*)q = v[1][3][0]; *(f32x4*)(q + 4) = v[1][3][1]; } }
        }
        f32x4 w0[2], w1[2], w2[2];
#pragma unroll
        for (int n = 0; n < 2; ++n) { w0[n] = *(const f32x4*)(wconv + ch0 + 4 * n); w1[n] = *(const f32x4*)(wconv + DFF + ch0 + 4 * n); w2[n] = *(const f32x4*)(wconv + 2 * DFF + ch0 + 4 * n); }
#define DPP_F(oldv, srcv, ctrl) __builtin_bit_cast(float, __builtin_amdgcn_update_dpp(__builtin_bit_cast(int, (float)(oldv)), __builtin_bit_cast(int, (float)(srcv)), (ctrl), 0xf, 0xf, false))
#pragma unroll
        for (int ai = 0; ai < 2; ++ai) { const int sp = 2 * ai + wr;
            f32x4 hup[2], hdn[2];
#pragma unroll
            for (int n = 0; n < 2; ++n) {
                hup[n] = (sp > 0) ? *(const PG8_LAS f32x4*)(halo + (1 * 4 + sp - 1) * 128 + colh + 4 * n) : (f32x4){0.f, 0.f, 0.f, 0.f};
                hdn[n] = (sp < 3) ? *(const PG8_LAS f32x4*)(halo + (0 * 4 + sp + 1) * 128 + colh + 4 * n) : (f32x4){0.f, 0.f, 0.f, 0.f}; }
#pragma unroll
            for (int m = 0; m < 4; ++m) {
                f32x4 o[2];
#pragma unroll
                for (int n = 0; n < 2; ++n)
#pragma unroll
                    for (int j = 0; j < 4; ++j) {
                        const float gg = g[ai][m][n][j];
                        float ub, db;
                        if (m > 0) ub = DPP_F(0.f, g[ai][m > 0 ? m - 1 : 0][n][j], 0x121); else ub = hup[n][j];
                        if (m < 3) db = DPP_F(0.f, g[ai][m < 3 ? m + 1 : 3][n][j], 0x12f); else db = hdn[n][j];
                        const float up = DPP_F(ub, gg, 0x111), dn = DPP_F(db, gg, 0x101);
                        const float cv = w0[n][j] * up + w1[n][j] * gg + w2[n][j] * dn;
                        o[n][j] = cv * __builtin_amdgcn_rcpf(1.f + __expf(-cv)) * v[ai][m][n][j];
                    }
                __builtin_nontemporal_store(pack8(o[0], o[1]), (u32x4*)(F + (size_t)(u.pm * BM + ai * HALF + wr * 64 + m * 16 + fr) * DFF + ch0));
            }
        }
#undef DPP_F
    }
};

template <class Epi, class Sched, bool ALIGN_EPI, bool I8 = false>
__device__ __forceinline__ void gemm_phase(PG8_LAS unsigned char* lds, const Gemm g, const Sched& S, const Epi& E, const int tid) {
    typedef typename Epi::acc_t acc_t;
    const int wid = __builtin_amdgcn_readfirstlane(tid >> 6), lane = tid & 63, wr = wid >> 2, wc = wid & 3, fr = lane & 15, fq = lane >> 4;
    const int K = g.K, rbA = I8 ? g.lda : g.lda * 2, rbB = I8 ? K : K * 2, nt = rbB / (BK * 2);
    unsigned voffA[2], voffB[2];
#pragma unroll
    for (int i = 0; i < 2; ++i) { int R, C; stage_rc(tid * 16 + i * 8192, R, C); const int Rb = Epi::PERM ? ((R & ~31) + perm32(R & 31)) : R;
        voffA[i] = (unsigned)(R * rbA + C * 2); voffB[i] = (unsigned)(Rb * rbB + C * 2); }
    const size_t kstep = (size_t)(BK * 2);
    const size_t hstepA = (size_t)HALF * rbA, hstepB = (size_t)HALF * rbB;
    const size_t tstepA = 2 * hstepA, tstepB = 2 * hstepB;
    const unsigned ldsw = (unsigned)wid * 1024u;
    const int aoff = lds_byte(wr * 64 + fr, fq * 8), boff = lds_byte(wc * 32 + fr, fq * 8);
#define PG8_KOFF(kt) ((size_t)(kt) * kstep + (((kt) >= g.kj_t) ? (size_t)g.kj_bytes : (size_t)0))
#define PG8_SA(b, h) (((b) * 2 + (h)) * HTB)
#define PG8_SB(b, h) ((4 + (b) * 2 + (h)) * HTB)
#define PG8_STAGE(bufoff, gbase, voff) do { _Pragma("unroll") for (int _i = 0; _i < 2; ++_i) \
        __builtin_amdgcn_global_load_lds((const unsigned*)((const char*)(gbase) + (voff)[_i]), (PG8_LAS unsigned*)(lds + (bufoff) + ldsw + _i * 8192), 16, 0, 0); } while (0)
#define PG8_LDA(dst, b, h) do { _Pragma("unroll") for (int m = 0; m < 4; ++m) _Pragma("unroll") for (int k = 0; k < 2; ++k) dst[m][k] = *(const PG8_LAS bf16x8*)(lds + PG8_SA(b, h) + aoff + m * 2048 + k * 1024); } while (0)
#define PG8_LDB(dst, b, h) do { _Pragma("unroll") for (int n = 0; n < 2; ++n) _Pragma("unroll") for (int k = 0; k < 2; ++k) dst[n][k] = *(const PG8_LAS bf16x8*)(lds + PG8_SB(b, h) + boff + n * 2048 + k * 1024); } while (0)
#define PG8_MMA(ai, bj, At, Bt) do { __builtin_amdgcn_s_setprio(1); _Pragma("unroll") for (int m = 0; m < 4; ++m) _Pragma("unroll") for (int n = 0; n < 2; ++n) _Pragma("unroll") for (int k = 0; k < 2; ++k) { \
        if constexpr (I8) acc[ai][bj][m][n] = __builtin_amdgcn_mfma_i32_16x16x64_i8(__builtin_bit_cast(i32x4, Bt[n][k]), __builtin_bit_cast(i32x4, At[m][k]), acc[ai][bj][m][n], 0, 0, 0); \
        else acc[ai][bj][m][n] = __builtin_amdgcn_mfma_f32_16x16x32_bf16(Bt[n][k], At[m][k], acc[ai][bj][m][n], 0, 0, 0); } __builtin_amdgcn_s_setprio(0); } while (0)
#define PG8_WAIT_V(n) asm volatile("s_waitcnt vmcnt(" #n ")" ::: "memory")
#define PG8_WAIT_L(n) asm volatile("s_waitcnt lgkmcnt(" #n ")" ::: "memory")
#define PG8_BAR __builtin_amdgcn_s_barrier()
#define PG8_SCHED __builtin_amdgcn_sched_barrier(0)
    Unit cur, nxt; int ui = 0;
    if (!S.next(0, cur)) return;
    acc_t acc[2][2][4][2];
#pragma unroll
    for (int a = 0; a < 2; ++a)
#pragma unroll
        for (int b = 0; b < 2; ++b)
#pragma unroll
            for (int m = 0; m < 4; ++m)
#pragma unroll
                for (int n = 0; n < 2; ++n) acc[a][b][m][n] = (acc_t){0, 0, 0, 0};
    bf16x8 At[4][2], B0[2][2], B1[2][2];
    const char* cA = (const char*)g.A + (size_t)cur.pm * tstepA; const char* cB = (const char*)g.Bt + (size_t)cur.pnb * tstepB;
    S.a_ready(cur);
    PG8_STAGE(PG8_SB(0, 0), cB, voffB); PG8_STAGE(PG8_SB(0, 1), cB + hstepB, voffB); PG8_STAGE(PG8_SA(0, 0), cA, voffA); PG8_STAGE(PG8_SA(0, 1), cA + hstepA, voffA);
    if (wr == 1) PG8_BAR;
    PG8_WAIT_V(2); PG8_BAR;
    PG8_STAGE(PG8_SB(1, 0), cB + kstep, voffB); PG8_STAGE(PG8_SA(1, 0), cA + kstep, voffA); PG8_STAGE(PG8_SB(1, 1), cB + hstepB + kstep, voffB);
    PG8_WAIT_V(6); PG8_BAR;
    for (;;) {
        const bool has_next = S.next(ui + 1, nxt);
        const char* nA = has_next ? (const char*)g.A + (size_t)nxt.pm * tstepA : cA; const char* nB = has_next ? (const char*)g.Bt + (size_t)nxt.pnb * tstepB : cB;
        for (int t = 0; t < nt; t += 2) {
            const bool last = (t == nt - 2);
            if constexpr (Epi::HAS_MID) { if (t == g.kj_t) E.mid(acc, cur, wr, wc, fr, fq); }
            const char* a1 = cA + PG8_KOFF(t + 1);
            const char* a2 = last ? nA : cA + PG8_KOFF(t + 2); const char* b2 = last ? nB : cB + (size_t)(t + 2) * kstep;
            const char* a3 = a2 + kstep; const char* b3 = b2 + kstep;
            if (last && has_next) S.a_ready(nxt);
            PG8_LDB(B0, 0, 0); PG8_LDB(B1, 0, 1); PG8_SCHED; PG8_LDA(At, 0, 0); PG8_STAGE(PG8_SA(1, 1), a1 + hstepA, voffA);
            PG8_WAIT_V(8); PG8_WAIT_L(0); PG8_BAR; PG8_MMA(0, 0, At, B0); PG8_MMA(0, 1, At, B1); PG8_BAR; PG8_SCHED;
            PG8_LDA(At, 0, 1); PG8_STAGE(PG8_SB(0, 0), b2, voffB); PG8_STAGE(PG8_SB(0, 1), b2 + hstepB, voffB); PG8_STAGE(PG8_SA(0, 0), a2, voffA);
            PG8_WAIT_V(8); PG8_WAIT_L(0); PG8_BAR; PG8_MMA(1, 0, At, B0); PG8_MMA(1, 1, At, B1); PG8_BAR; PG8_SCHED;
            PG8_LDB(B0, 1, 0); PG8_LDB(B1, 1, 1); PG8_SCHED; PG8_LDA(At, 1, 0); PG8_STAGE(PG8_SA(0, 1), a2 + hstepA, voffA);
            PG8_WAIT_V(8); PG8_WAIT_L(0); PG8_BAR; PG8_MMA(0, 0, At, B0); PG8_MMA(0, 1, At, B1); PG8_BAR; PG8_SCHED;
            PG8_LDA(At, 1, 1); PG8_STAGE(PG8_SB(1, 0), b3, voffB); PG8_STAGE(PG8_SB(1, 1), b3 + hstepB, voffB); PG8_STAGE(PG8_SA(1, 0), a3, voffA);
            PG8_WAIT_V(8); PG8_WAIT_L(0); PG8_BAR; PG8_MMA(1, 0, At, B0); PG8_MMA(1, 1, At, B1); PG8_BAR; PG8_SCHED;
        }
        if constexpr (ALIGN_EPI) { if (wr == 0) PG8_BAR; }
        E(acc, cur, wr, wc, fr, fq); S.done(cur);
        if (!has_next) break;
#pragma unroll
        for (int a = 0; a < 2; ++a)
#pragma unroll
            for (int b = 0; b < 2; ++b)
#pragma unroll
                for (int m = 0; m < 4; ++m)
#pragma unroll
                    for (int n = 0; n < 2; ++n) acc[a][b][m][n] = (acc_t){0, 0, 0, 0};
        cur = nxt; cA = nA; cB = nB; ++ui;
        if constexpr (ALIGN_EPI) { if (wr == 1) PG8_BAR; }
    }
    PG8_WAIT_V(0);
    if constexpr (!ALIGN_EPI) { if (wr == 0) PG8_BAR; }
    PG8_BAR;
#undef PG8_KOFF
#undef PG8_SA
#undef PG8_SB
#undef PG8_STAGE
#undef PG8_LDA
#undef PG8_LDB
#undef PG8_MMA
#undef PG8_WAIT_V
#undef PG8_WAIT_L
#undef PG8_BAR
#undef PG8_SCHED
}
}

namespace att {
typedef unsigned short bf16_t;
using bf16x8 = __attribute__((ext_vector_type(8))) short;
using s16x4  = __attribute__((ext_vector_type(4))) short;
using f32x16 = __attribute__((ext_vector_type(16))) float;
using u32x4  = __attribute__((ext_vector_type(4))) unsigned;
constexpr int D = 128, KVBLK = 64;
constexpr float SCALE = 0.088388347648318440f, THR = 8.f;
constexpr int SHM_V = KVBLK * D * 2, SHM_K = KVBLK * D * 2, SHM_ATTN = 2 * SHM_V + 2 * SHM_K + 8 * 64 * 4;
#define KSWZ(row, colB) ((row) * 256 + ((colB) ^ (((row) & 7) << 4)))
#define SBAR() __builtin_amdgcn_sched_barrier(0)
__device__ __forceinline__ int crow(int r, int hi) { return (r & 3) + 8 * (r >> 2) + 4 * hi; }
__device__ __forceinline__ unsigned cvtpk(float lo, float hi) { unsigned r; asm volatile("v_cvt_pk_bf16_f32 %0, %1, %2" : "=v"(r) : "v"(lo), "v"(hi)); return r; }
__device__ __forceinline__ bf16x8 ld8(const bf16_t* p) { return *reinterpret_cast<const bf16x8*>(p); }

__device__ __forceinline__ void partialSM(f32x16& p0, f32x16& p1, float& m_reg, float& mn, float& alpha) {
  constexpr float C = SCALE * 1.4426950408889634f;
  float pmax = p0[0];
#pragma unroll
  for (int r = 1; r < 16; ++r) pmax = fmaxf(pmax, p0[r]);
#pragma unroll
  for (int r = 0; r < 16; ++r) pmax = fmaxf(pmax, p1[r]);
  { auto rr = __builtin_amdgcn_permlane32_swap(__float_as_uint(pmax), __float_as_uint(pmax), false, false);
    pmax = fmaxf(__uint_as_float(rr[0]), __uint_as_float(rr[1])); }
  if (__builtin_expect(__all(pmax - m_reg <= THR / SCALE), 1)) { mn = m_reg; alpha = 1.f; }
  else { mn = fmaxf(m_reg, pmax); alpha = __builtin_amdgcn_exp2f((m_reg - mn) * C); m_reg = mn; }
  float mnC = -mn * C;
#pragma unroll
  for (int r = 0; r < 16; ++r) p0[r] = fmaf(p0[r], C, mnC);
#pragma unroll
  for (int r = 0; r < 16; ++r) p1[r] = fmaf(p1[r], C, mnC);
#pragma unroll
  for (int r = 0; r < 16; ++r) p0[r] = __builtin_amdgcn_exp2f(p0[r]);
}
__device__ __forceinline__ void finishSM(f32x16& p0, f32x16& p1, float alpha, float& l_reg, bf16x8& pa0, bf16x8& pa1, bf16x8& pa2, bf16x8& pa3) {
#pragma unroll
  for (int r = 0; r < 16; ++r) p1[r] = __builtin_amdgcn_exp2f(p1[r]);
  float ps = 0;
#pragma unroll
  for (int r = 0; r < 16; ++r) ps += p0[r];
#pragma unroll
  for (int r = 0; r < 16; ++r) ps += p1[r];
  { auto rr = __builtin_amdgcn_permlane32_swap(__float_as_uint(ps), __float_as_uint(ps), false, false);
    ps = __uint_as_float(rr[0]) + __uint_as_float(rr[1]); }
  l_reg = l_reg * alpha + ps;
#define PK4(P, BASE, OUT) do { unsigned a0 = cvtpk(P[BASE + 0], P[BASE + 1]), a1 = cvtpk(P[BASE + 2], P[BASE + 3]);   \
    unsigned b0 = cvtpk(P[BASE + 4], P[BASE + 5]), b1 = cvtpk(P[BASE + 6], P[BASE + 7]);                              \
    auto r0 = __builtin_amdgcn_permlane32_swap(a0, b0, false, false); auto r1 = __builtin_amdgcn_permlane32_swap(a1, b1, false, false); \
    u32x4 w = {r0[0], r1[0], r0[1], r1[1]}; OUT = *reinterpret_cast<bf16x8*>(&w); } while (0)
  PK4(p0, 0, pa0); PK4(p0, 8, pa1); PK4(p1, 0, pa2); PK4(p1, 8, pa3);
#undef PK4
}
__device__ __forceinline__ void qkt(f32x16& p0, f32x16& p1, const char* Ks, const bf16x8* qr, int r32, int hi) {
  p0 = f32x16{}; p1 = f32x16{};
#pragma unroll
  for (int d0 = 0; d0 < 8; ++d0) { int cb = (d0 * 16 + hi * 8) * 2;
    bf16x8 b0 = *reinterpret_cast<const bf16x8*>(Ks + KSWZ(r32, cb));
    bf16x8 b1 = *reinterpret_cast<const bf16x8*>(Ks + KSWZ(32 + r32, cb));
    p0 = __builtin_amdgcn_mfma_f32_32x32x16_bf16(b0, qr[d0], p0, 0, 0, 0);
    p1 = __builtin_amdgcn_mfma_f32_32x32x16_bf16(b1, qr[d0], p1, 0, 0, 0); }
}
__device__ __forceinline__ int v_st(int k, int c) { const int kk = (k & ~0xC) | ((k & 4) << 1) | ((k & 8) >> 1); return ((kk >> 3) * 4 + (c >> 5)) * 512 + ((kk & 7) * 32 + (c & 31)) * 2; }
__device__ __forceinline__ int v_rd_base(int lane) { return ((lane & 3) << 3) | (((lane >> 2) & 3) << 6) | (((lane >> 4) & 1) << 5) | (((lane >> 5) & 1) << 8); }
constexpr int v_rd_off(int d0, int ks, int half) { return d0 * 512 + ks * 4096 + half * 2048; }
template <int OFF> __device__ __forceinline__ s16x4 tr_read(int vb) {
  s16x4 r; asm volatile("ds_read_b64_tr_b16 %0, %1 offset:%2" : "=&v"(r) : "v"(vb), "i"(OFF) : "memory"); return r;
}
template <int D0> __device__ __forceinline__ void pv_one(f32x16& od, int vb, bf16x8 pa0, bf16x8 pa1, bf16x8 pa2, bf16x8 pa3) {
  const s16x4 l0 = tr_read<v_rd_off(D0, 0, 0)>(vb), h0 = tr_read<v_rd_off(D0, 0, 1)>(vb), l1 = tr_read<v_rd_off(D0, 1, 0)>(vb), h1 = tr_read<v_rd_off(D0, 1, 1)>(vb);
  const s16x4 l2 = tr_read<v_rd_off(D0, 2, 0)>(vb), h2 = tr_read<v_rd_off(D0, 2, 1)>(vb), l3 = tr_read<v_rd_off(D0, 3, 0)>(vb), h3 = tr_read<v_rd_off(D0, 3, 1)>(vb);
  asm volatile("s_waitcnt lgkmcnt(0)" ::: "memory"); SBAR();
#define PK(L, H) (bf16x8){L[0], L[1], L[2], L[3], H[0], H[1], H[2], H[3]}
  od = __builtin_amdgcn_mfma_f32_32x32x16_bf16(pa0, PK(l0, h0), od, 0, 0, 0);
  od = __builtin_amdgcn_mfma_f32_32x32x16_bf16(pa1, PK(l1, h1), od, 0, 0, 0);
  od = __builtin_amdgcn_mfma_f32_32x32x16_bf16(pa2, PK(l2, h2), od, 0, 0, 0);
  od = __builtin_amdgcn_mfma_f32_32x32x16_bf16(pa3, PK(l3, h3), od, 0, 0, 0);
#undef PK
}
__device__ __forceinline__ void pv_d0(f32x16* o, int vb, bf16x8 pa0, bf16x8 pa1, bf16x8 pa2, bf16x8 pa3) {
  pv_one<0>(o[0], vb, pa0, pa1, pa2, pa3); pv_one<1>(o[1], vb, pa0, pa1, pa2, pa3); pv_one<2>(o[2], vb, pa0, pa1, pa2, pa3); pv_one<3>(o[3], vb, pa0, pa1, pa2, pa3);
}
__device__ __forceinline__ void band_mask(f32x16& p0, f32x16& p1, int dq, int hi) {
#pragma unroll
  for (int r = 0; r < 16; ++r) { const int d = dq - crow(r, hi); if (d > 128 || d < -128) p0[r] = -1e30f; const int d2 = d - 32; if (d2 > 128 || d2 < -128) p1[r] = -1e30f; }
}

struct Src { const bf16_t* KA; const bf16_t* VA; int nA; const bf16_t* KB; const bf16_t* VB; int nB; int qpos0, kpos0, masked; };

__device__ __forceinline__ void attn_unit(const bf16_t* __restrict__ Qw, bf16_t* __restrict__ Ow, const Src S, float sink, char* lds, const int tid, const int ldo) {
  const int wid = tid >> 6, lane = tid & 63, r32 = lane & 31, hi = lane >> 5;
  char* V_lds = lds; char* K_lds = lds + 2 * SHM_V;
  float* ws = (float*)(lds + 2 * SHM_V + 2 * SHM_K) + wid * 64; float* li_l = ws; float* al_l = ws + 32;
  float m_reg = sink * (1.f / SCALE), l_reg = 1.f; f32x16 o[4] = {}; bf16x8 qr[8];
#pragma unroll
  for (int d0 = 0; d0 < 8; ++d0) qr[d0] = ld8(Qw + d0 * 16);
  const int sr = tid >> 4, sc = (tid & 15) * 8, vst0 = v_st(sr, sc), vst1 = v_st(32 + sr, sc);
  const int vb0 = (int)(uintptr_t)V_lds + v_rd_base(lane);
  const int qpos = S.qpos0 + 32 * (wid & 3) + r32;
  struct { bf16x8 vs0, vs1, ks0, ks1; } sr_[2];
#define SLOAD(i, t) do { const int _t = (t); const bool _a = _t < S.nA; const int _ld = _a ? KVW : INW; \
    const size_t _o = _a ? (size_t)_t * (64 * KVW) : (size_t)(_t - S.nA) * ((size_t)64 * INW); \
    const bf16_t* _k = (_a ? S.KA : S.KB) + _o + (size_t)sr * _ld + sc; const bf16_t* _v = (_a ? S.VA : S.VB) + _o + (size_t)sr * _ld + sc; \
    sr_[i].vs0 = ld8(_v); sr_[i].vs1 = ld8(_v + (size_t)32 * _ld); sr_[i].ks0 = ld8(_k); sr_[i].ks1 = ld8(_k + (size_t)32 * _ld); } while (0)
#define SWRITE(b, i) do { *(bf16x8*)(V_lds + (b) * SHM_V + vst0) = sr_[i].vs0;          \
    *(bf16x8*)(V_lds + (b) * SHM_V + vst1) = sr_[i].vs1; int kc = sc * 2;               \
    *(bf16x8*)(K_lds + (b) * SHM_K + KSWZ(sr, kc)) = sr_[i].ks0;                       \
    *(bf16x8*)(K_lds + (b) * SHM_K + KSWZ(32 + sr, kc)) = sr_[i].ks1; } while (0)
#define SWAIT() asm volatile("s_waitcnt vmcnt(4)" ::: "memory")
#define RESC(a) do { if (__any((a) < 1.f)) { if (hi == 0) al_l[r32] = (a); asm volatile("s_waitcnt lgkmcnt(0)" ::: "memory"); \
    _Pragma("unroll") for (int d = 0; d < 4; ++d) _Pragma("unroll") for (int r = 0; r < 16; ++r) o[d][r] *= al_l[crow(r, hi)]; } } while (0)
#define MASK(P0, P1, t) do { const int _t = (t); if (S.masked && _t >= S.nA) { const int _kp0 = S.kpos0 + 64 * (_t - S.nA); \
    if ((_kp0 >> 7) != (S.qpos0 >> 7)) band_mask(P0, P1, qpos - _kp0, hi); } } while (0)
  f32x16 pA0, pA1, pB0, pB1; float mnA, mnB, alA, alB; bf16x8 pa0, pa1, pa2, pa3; const int NT = S.nA + S.nB;
  constexpr int SE = 0, SO = 1;
  SLOAD(SE, 0); asm volatile("s_waitcnt vmcnt(0)" ::: "memory"); SWRITE(0, SE); __syncthreads();
  qkt(pA0, pA1, K_lds, qr, r32, hi); MASK(pA0, pA1, 0); partialSM(pA0, pA1, m_reg, mnA, alA);
  SLOAD(SO, 1); if (2 < NT) SLOAD(SE, 2);
  SWAIT(); SWRITE(1, SO); __syncthreads();
  for (int j = 1; j + 1 < NT; j += 2) {
    SBAR(); qkt(pB0, pB1, K_lds + SHM_K, qr, r32, hi);
    finishSM(pA0, pA1, alA, l_reg, pa0, pa1, pa2, pa3); SBAR();
    SLOAD(SO, j + 2); SBAR();
    pv_d0(o, vb0, pa0, pa1, pa2, pa3); MASK(pB0, pB1, j); partialSM(pB0, pB1, m_reg, mnB, alB);
    __syncthreads(); SWAIT(); SWRITE(0, SE);
    RESC(alB); __syncthreads();
    SBAR(); qkt(pA0, pA1, K_lds, qr, r32, hi);
    finishSM(pB0, pB1, alB, l_reg, pa0, pa1, pa2, pa3); SBAR();
    if (j + 3 < NT) SLOAD(SE, j + 3); SBAR();
    pv_d0(o, vb0 + (int)SHM_V, pa0, pa1, pa2, pa3); MASK(pA0, pA1, j + 1); partialSM(pA0, pA1, m_reg, mnA, alA);
    __syncthreads(); SWAIT(); SWRITE(1, SO);
    RESC(alA); __syncthreads();
  }
  SBAR(); qkt(pB0, pB1, K_lds + SHM_K, qr, r32, hi);
  finishSM(pA0, pA1, alA, l_reg, pa0, pa1, pa2, pa3); SBAR();
  pv_d0(o, vb0, pa0, pa1, pa2, pa3); MASK(pB0, pB1, NT - 1); partialSM(pB0, pB1, m_reg, mnB, alB);
  __syncthreads(); RESC(alB);
  finishSM(pB0, pB1, alB, l_reg, pa0, pa1, pa2, pa3); SBAR();
  pv_d0(o, vb0 + (int)SHM_V, pa0, pa1, pa2, pa3);
  if (hi == 0) li_l[r32] = l_reg; asm volatile("s_waitcnt lgkmcnt(0)" ::: "memory");
  float rli[16];
#pragma unroll
  for (int r = 0; r < 16; ++r) rli[r] = __builtin_amdgcn_rcpf(li_l[crow(r, hi)]);
  { char* stg = lds + SHM_ATTN + wid * 4096;
#pragma unroll
    for (int p = 0; p < 2; ++p) {
#pragma unroll
      for (int rr = 0; rr < 8; ++rr) { const int r = 8 * p + rr, lrow = (rr & 3) + 8 * (rr >> 2) + 4 * hi;
#pragma unroll
        for (int d0 = 0; d0 < 4; ++d0) *(bf16_t*)(stg + lrow * 256 + (d0 * 32 + r32) * 2) = (bf16_t)(cvtpk(o[d0][r] * rli[r], 0.f) & 0xffffu); }
      asm volatile("s_waitcnt lgkmcnt(0)" ::: "memory");
#pragma unroll
      for (int k = 0; k < 4; ++k) { const int row = 4 * k + (lane >> 4), chunk = lane & 15;
        const u32x4 v = *(const u32x4*)(stg + row * 256 + chunk * 16);
        *(u32x4*)(Ow + (size_t)(16 * p + row) * ldo + chunk * 8) = v; }
      asm volatile("s_waitcnt lgkmcnt(0)" ::: "memory");
    } }
#undef SLOAD
#undef SWRITE
#undef SWAIT
#undef RESC
#undef MASK
}
}

#ifndef MK_N_LAUNCHES
#define MK_N_LAUNCHES 1
#endif
constexpr int N_PHASES = 11;
constexpr int N_LAUNCHES = MK_N_LAUNCHES;
constexpr int NWAVES = 8;

constexpr size_t MiB = 1u << 20;
constexpr size_t WS_CTL = 0, CTL_ZERO_BYTES = 262144;
constexpr size_t WS_MOD = 1 * MiB;
constexpr size_t WS_ROPE = 2 * MiB;
constexpr size_t WS_CK = 4 * MiB, WS_CV = 12 * MiB;
constexpr size_t WS_WCAT = 20 * MiB;
constexpr size_t WS_WA8 = 36 * MiB;
constexpr size_t WS_SB3 = 52 * MiB;
constexpr size_t WS_WMIX = 68 * MiB;
constexpr size_t WS_WUP8 = 100 * MiB;
constexpr size_t WS_SB2 = 229 * MiB;
constexpr size_t WS_WDN = 272 * MiB;
constexpr size_t WS_H = 358 * MiB;
constexpr size_t WS_WIN = 550 * MiB;
constexpr size_t WS_H8 = 614 * MiB;
constexpr size_t WS_PROJ = 710 * MiB;
constexpr size_t WS_F = 1226 * MiB;
constexpr size_t WS_SBG = 1742 * MiB;
constexpr size_t WS_SBV = 1760 * MiB;
constexpr size_t WS_W8 = 1670 * MiB;
constexpr size_t WS_SA = 53 * MiB, WS_SB = 54 * MiB;
constexpr size_t WS_END = 1770 * MiB;
static_assert(WS_WCAT + (size_t)4096 * 2048 * 2 <= WS_WA8 && WS_WA8 + (size_t)4096 * 4096 <= WS_SB3 && WS_SB3 + 4096 * 4 <= WS_WMIX && WS_WMIX + (size_t)4096 * 4096 * 2 <= WS_WUP8 && WS_WUP8 + (size_t)UPW * 4096 <= WS_SB2 && WS_SB2 + UPW * 4 <= WS_WDN &&
              WS_WDN + (size_t)4096 * DFF * 2 <= WS_H && WS_H + (size_t)MTOT * DM * 2 <= WS_WIN && WS_WIN + (size_t)8192 * 4096 * 2 <= WS_H8 && WS_H8 + (size_t)MTOT * DM <= WS_PROJ && WS_W8 + (size_t)14336 * 4096 <= WS_SBG && WS_SB3 + 4096 * 4 <= WS_SA && WS_SB + 14336 * 4 <= WS_WMIX &&
              WS_PROJ + (size_t)MTOT * INW * 2 <= WS_W8 && WS_F + (size_t)MTOT * DFF * 2 <= WS_SBG && WS_SBG + (size_t)96 * 4 * DFF * 4 <= WS_SBV && WS_SBV + (size_t)96 * 2 * DFF * 4 <= WS_END && WS_SA + MTOT * 4 <= WS_SB && WS_CV + 8 * MiB <= WS_WCAT, "d_ws map");
constexpr int CW_BAR = 4096;
constexpr int CW_CMAX = 16384;
constexpr int CW_CMAX2 = CW_CMAX + 14336;
constexpr int CW_CMAX3 = CW_CMAX2 + 22016;
static_assert((CW_BAR + 3456) <= CW_CMAX && (CW_CMAX3 + 4096) * 4 <= (int)CTL_ZERO_BYTES, "control words inside the per-call memset");
constexpr size_t O_NK = (size_t)MTOT * DM, O_NV = O_NK + (size_t)NCTX * KVW, O_END = O_NV + (size_t)NCTX * KVW;

constexpr int RING_BYTES = 131072, MISC_OFF = RING_BYTES + 320, LDS_BYTES = 147456;

#define LAS __attribute__((address_space(3)))
typedef unsigned short bf16;
typedef float f32x4 __attribute__((ext_vector_type(4)));
typedef unsigned u32x4 __attribute__((ext_vector_type(4)));
typedef unsigned u32x2 __attribute__((ext_vector_type(2)));

#define XB_TMO      128
#define XB_XCNT(j)  (256  + 64 * (j))
#define XB_XSUB(j)  (1280 + 64 * (j))
#define XB_XGEN(j)  (2304 + 64 * (j))
#define XB_TOP      3328
#define XB_TOPGEN   3392
#define XCD_BAR_WORDS 3456
#define XB_SPIN_CAP (1u << 22)
__device__ __forceinline__ unsigned xb_ld(unsigned* p)              { return __hip_atomic_load(p, __ATOMIC_RELAXED, __HIP_MEMORY_SCOPE_AGENT); }
__device__ __forceinline__ unsigned xb_add(unsigned* p, unsigned v) { return __hip_atomic_fetch_add(p, v, __ATOMIC_RELAXED, __HIP_MEMORY_SCOPE_AGENT); }
__device__ __forceinline__ unsigned xb_xcc_id() { return (unsigned)__builtin_amdgcn_s_getreg((3 << 11) | 20) & 0xFu; }
#define XB_SPIN(cond, bar) do { unsigned _sp = 0; while (cond) { __builtin_amdgcn_s_sleep(1); \
    if ((++_sp & 255u) == 0u) { if (xb_ld(&(bar)[XB_TMO])) break; if (_sp > XB_SPIN_CAP) { atomicAdd(&(bar)[XB_TMO], 1u); break; } } } } while (0)
struct XcdBarrier { unsigned* bar; unsigned x; volatile LAS unsigned* st; };
__device__ __forceinline__ XcdBarrier xcd_barrier_post(unsigned* bar, volatile LAS unsigned* st, const int tid) {
    XcdBarrier b; b.bar = bar; b.x = xb_xcc_id(); b.st = st;
    if (tid == 0) (void)xb_add(&bar[XB_XCNT(b.x)], 1u);
    return b;
}
__device__ __forceinline__ void xcd_barrier_complete(unsigned* bar, unsigned x, unsigned& nloc, unsigned& nx) {
    const unsigned G = gridDim.x * gridDim.y * gridDim.z;
    unsigned sum, cnt, mine, sp = 0u;
    for (;;) {
        sum = 0u; cnt = 0u; mine = 0u;
#pragma unroll
        for (unsigned j = 0; j < 16; ++j) { const unsigned c = xb_ld(&bar[XB_XCNT(j)]); sum += c; cnt += (c > 0u) ? 1u : 0u; mine = (j == x) ? c : mine; }
        if (sum == G) break;
        __builtin_amdgcn_s_sleep(1);
        if ((++sp & 255u) == 0u) { if (xb_ld(&bar[XB_TMO])) break; if (sp > XB_SPIN_CAP) { atomicAdd(&bar[XB_TMO], 1u); break; } }
    }
    nloc = mine > 0u ? mine : 1u; nx = cnt > 0u ? cnt : 1u;
}
__device__ __forceinline__ void xcd_barrier(const XcdBarrier& b, const int tid) {
    asm volatile("s_waitcnt vmcnt(0)" ::: "memory");
    __syncthreads();
    if (tid == 0) {
        unsigned* bar = b.bar;
        __builtin_amdgcn_s_waitcnt(0);
        unsigned nloc = b.st[0], nx = b.st[1];
        if (nloc == 0u) { xcd_barrier_complete(bar, b.x, nloc, nx); b.st[0] = nloc; b.st[1] = nx; }
        const unsigned old = xb_add(&bar[XB_XSUB(b.x)], 1u);
        const unsigned gen = old / nloc;
        if (old + 1u == (gen + 1u) * nloc) {
            __builtin_amdgcn_fence(__ATOMIC_RELEASE, "agent");
            asm volatile("s_waitcnt vmcnt(0)" ::: "memory");
            const unsigned og = xb_add(&bar[XB_TOP], 1u);
            const unsigned tg = og / nx;
            if (og + 1u == (tg + 1u) * nx) xb_add(&bar[XB_TOPGEN], 1u);
            else XB_SPIN(xb_ld(&bar[XB_TOPGEN]) == tg, bar);
            __builtin_amdgcn_fence(__ATOMIC_ACQUIRE, "agent");
            xb_add(&bar[XB_XGEN(b.x)], 1u);
            asm volatile("s_waitcnt vmcnt(0)" ::: "memory");
        } else {
            XB_SPIN(xb_ld(&bar[XB_XGEN(b.x)]) == gen, bar);
            __builtin_amdgcn_fence(__ATOMIC_ACQUIRE, "agent");
            asm volatile("s_waitcnt vmcnt(0)" ::: "memory");
        }
    }
    __syncthreads();
}

__device__ __forceinline__ int lane_id() { int l; asm volatile("v_mbcnt_lo_u32_b32 %0, -1, 0\n\tv_mbcnt_hi_u32_b32 %0, -1, %0" : "=v"(l)); return l; }
__device__ __forceinline__ float wave_sum(float v) {
#pragma unroll
    for (int o = 1; o < 64; o <<= 1) v += __shfl_xor(v, o);
    return v;
}
__device__ __forceinline__ unsigned pk2(float lo, float hi) { return pg8::cvt_pk_bf16(lo, hi); }
__device__ __forceinline__ void unpack8(const u32x4 w, float (&f)[8]) {
#pragma unroll
    for (int e = 0; e < 4; ++e) { f[2 * e] = pg8::bf_lo(w[e]); f[2 * e + 1] = pg8::bf_hi(w[e]); }
}
__device__ __forceinline__ u32x4 pack8f(const float (&f)[8]) { u32x4 w; w.x = pk2(f[0], f[1]); w.y = pk2(f[2], f[3]); w.z = pk2(f[4], f[5]); w.w = pk2(f[6], f[7]); return w; }

struct Args { const float* in[21]; float* out; unsigned char* ws; int ph_lo, ph_hi; };
static_assert(sizeof(Args) == 21 * 8 + 8 + 8 + 8, "Args has no padding");
typedef const __attribute__((address_space(4))) Args* KA;
__device__ __forceinline__ KA launder(KA p) { asm volatile("" : "+s"(p)); return p; }
enum { I_XP = 0, I_XS, I_CK, I_CV, I_C, I_CCTX, I_WMOD, I_BMOD, I_GPREMIX, I_WIN, I_WSCONV, I_SINK, I_WAO, I_WCO, I_WMIX, I_GPOSTMIX, I_GPREFFN, I_WUP, I_WFCONV, I_WDN, I_GPOSTFFN };

__device__ __forceinline__ void p0_mod(KA a, unsigned char* lds_g, int tid, int G) {
    LAS float* sT = (LAS float*)lds_g;
    LAS float* red = (LAS float*)(lds_g + 49152);
    const float* w_mod = a->in[I_WMOD]; const float* b_mod = a->in[I_BMOD]; const float* cv = a->in[I_C]; const float* cctx = a->in[I_CCTX];
    float* mod = (float*)(a->ws + WS_MOD);
    const int cg = tid % 24, rg = tid / 24;
    for (int cbk = blockIdx.x; cbk < 256; cbk += G) {
        f32x4 acc[9];
#pragma unroll
        for (int s = 0; s < 9; ++s) acc[s] = (f32x4){0.f, 0.f, 0.f, 0.f};
        for (int kc = 0; kc < 4; ++kc) {
            __syncthreads();
            for (int idx = tid; idx < 9 * 1024; idx += NWAVES * 64) { const int s = idx >> 10, k = idx & 1023;
                const float c = (s == 0) ? cctx[kc * 1024 + k] : cv[(s - 1) * DM + kc * 1024 + k];
                sT[k * 12 + s] = c / (1.f + expf(-c)); }
            __syncthreads();
            if (tid < 504) {
                const float* wp = w_mod + (size_t)(kc * 1024) * 24576 + cbk * 96 + cg * 4;
#pragma unroll 4
                for (int kk = rg; kk < 1024; kk += 21) {
                    const f32x4 w = __builtin_nontemporal_load((const f32x4*)(wp + (size_t)kk * 24576));
                    const f32x4 s0 = *(const LAS f32x4*)(sT + kk * 12), s1 = *(const LAS f32x4*)(sT + kk * 12 + 4), s2 = *(const LAS f32x4*)(sT + kk * 12 + 8);
                    acc[0] += w * s0.x; acc[1] += w * s0.y; acc[2] += w * s0.z; acc[3] += w * s0.w;
                    acc[4] += w * s1.x; acc[5] += w * s1.y; acc[6] += w * s1.z; acc[7] += w * s1.w; acc[8] += w * s2.x;
                }
            }
        }
        if (tid < 504) {
#pragma unroll
            for (int s = 0; s < 9; ++s) *(LAS f32x4*)(red + (rg * 9 + s) * 96 + cg * 4) = acc[s];
        }
        __syncthreads();
        for (int o = tid; o < 9 * 96; o += NWAVES * 64) { const int s = o / 96, cc = o % 96; float sum = 0.f;
            for (int r2 = 0; r2 < 21; ++r2) sum += red[(r2 * 9 + s) * 96 + cc];
            const int col = cbk * 96 + cc, mi = col >> 12, c = col & 4095; float v = sum + b_mod[col];
            if (mi == 1) v = a->in[I_GPREMIX][c] * (1.f + v); else if (mi == 2) v *= a->in[I_GPOSTMIX][c]; else if (mi == 4) v = a->in[I_GPREFFN][c] * (1.f + v); else if (mi == 5) v *= a->in[I_GPOSTFFN][c];
            mod[(size_t)s * 24576 + col] = v; }
        __syncthreads();
    }
}
__device__ __forceinline__ int cvt_rowmap(int n, int rowmap) {
    if (rowmap == 1) { int r = n; if (n < 5120) { const int d = n & 127; r = (n & ~127) | ((d & 64) | ((d & 16) << 1) | ((d & 8) << 1) | ((d & 4) << 1) | ((d & 32) >> 3) | (d & 3)); }
        return r - 4096; }
    return n;
}
__device__ __forceinline__ int wup8_row(int n) { const int isv = n >= DFF, ch = isv ? n - DFF : n; return (ch >> 7) * 256 + isv * 128 + (ch & 127); }
__device__ __forceinline__ int w8_row(int n) {
    if (n < 5120) { const int d = n & 127; return (n & ~127) | ((d & 64) | ((d & 16) << 1) | ((d & 8) << 1) | ((d & 4) << 1) | ((d & 32) >> 3) | (d & 3)); }
    return n < 6144 ? n : n - 6144;
}
struct CvtItem { const float* W; bf16* dst; int N, ldk, koff, kb, nb, rowmap; };
__device__ __forceinline__ CvtItem cvt_decode(KA a, int it) {
    constexpr int I_IN = 64 * 80, I_AO = 64 * 16, I_CO = 32 * 16, I_MX = 64 * 16, I_UP = 64 * 86;
    CvtItem c; int r = it, nbn; c.koff = 0; c.rowmap = 0;
    if (r < I_IN) { c.W = a->in[I_WIN]; c.N = INW; c.dst = (bf16*)(a->ws + WS_WIN); c.ldk = 4096; nbn = 80; c.rowmap = 1; }
    else if ((r -= I_IN) < I_AO) { c.W = a->in[I_WAO]; c.N = 4096; c.dst = (bf16*)(a->ws + WS_WCAT); c.ldk = 2048; nbn = 16; c.rowmap = 3; }
    else if ((r -= I_AO) < I_CO) { c.W = a->in[I_WCO]; c.N = 4096; c.dst = (bf16*)(a->ws + WS_WCAT); c.ldk = 2048; nbn = 16; }
    else if ((r -= I_CO) < I_MX) { c.W = a->in[I_WMIX]; c.N = 4096; c.dst = (bf16*)(a->ws + WS_WMIX); c.ldk = 4096; nbn = 16; }
    else if ((r -= I_MX) < I_UP) { c.W = a->in[I_WUP]; c.N = UPW; c.dst = (bf16*)(a->ws + WS_WUP8); c.ldk = 4096; nbn = 86; c.rowmap = 2; }
    else { r -= I_UP; c.W = a->in[I_WDN]; c.N = 4096; c.dst = (bf16*)(a->ws + WS_WDN); c.ldk = DFF; nbn = 16; }
    c.kb = r / nbn; c.nb = r % nbn; return c;
}
#define CVT_LOAD(V, C) do { const float* _s = (C).W + (size_t)((C).kb * 64 + wave * 8) * (C).N + (C).nb * 256 + 4 * lane; \
        _Pragma("unroll") for (int j = 0; j < 8; ++j) V[j] = __builtin_nontemporal_load((const f32x4*)(_s + (size_t)j * (C).N)); } while (0)
#define CVT_PUT(V, C, T) do { _Pragma("unroll") for (int i = 0; i < 4; ++i) { u32x4 w; w.x = pk2(V[0][i], V[1][i]); w.y = pk2(V[2][i], V[3][i]); w.z = pk2(V[4][i], V[5][i]); w.w = pk2(V[6][i], V[7][i]); \
            *(LAS u32x4*)((T) + (4 * lane + i) * 144 + wave * 16) = w; } \
        __syncthreads(); \
        _Pragma("unroll") for (int q = 0; q < 4; ++q) { const int idx = q * 512 + tid, row = idx >> 3, ch = idx & 7; \
            const u32x4 w = *(const LAS u32x4*)((T) + row * 144 + ch * 16); \
            u32x4* _d = (u32x4*)((C).dst + (size_t)cvt_rowmap((C).nb * 256 + row, (C).rowmap) * (C).ldk + (C).koff + (C).kb * 64 + ch * 8); \
            if ((C).rowmap != 1) __builtin_nontemporal_store(w, _d); else *_d = w; } } while (0)
#define CVT_AMAX(V, C, T) do { f32x4 _m = (f32x4){0.f, 0.f, 0.f, 0.f}; _Pragma("unroll") for (int j = 0; j < 8; ++j) _m = __builtin_elementwise_max(_m, __builtin_elementwise_abs(V[j])); \
        *(LAS f32x4*)((T) + wave * 1024 + lane * 16) = _m; __syncthreads(); \
        if (tid < 256) { float _x = 0.f; _Pragma("unroll") for (int w_ = 0; w_ < 8; ++w_) _x = fmaxf(_x, *(const LAS float*)((T) + w_ * 1024 + tid * 4)); \
            atomicMax((unsigned*)(a->ws + WS_CTL) + ((C).rowmap == 1 ? CW_CMAX + w8_row((C).nb * 256 + tid) : (C).rowmap == 2 ? CW_CMAX2 + wup8_row((C).nb * 256 + tid) : CW_CMAX3 + (C).nb * 256 + tid), __float_as_uint(_x)); } } while (0)
#define CVT_ITEM(V, C, T) do { if (((C).rowmap == 1 && ((C).nb < 16 || (C).nb >= 48)) || (C).rowmap == 2 || (C).rowmap == 3) CVT_AMAX(V, C, T); else { CVT_PUT(V, C, T); \
        if ((C).rowmap == 1 && (C).nb < 24) CVT_AMAX(V, C, L + 81920); } } while (0)
__device__ __forceinline__ void p0_convert(KA a, int vcu, int G, int wave, int lane, int tid, int gtid, int NGT, LAS unsigned char* L) {
    constexpr int NIT = 64 * 80 + 64 * 16 + 32 * 16 + 64 * 16 + 64 * 86 + 172 * 16;
    { f32x4 va[8], vb[8]; CvtItem ca, cb; int it = vcu; LAS unsigned char* T0 = L; LAS unsigned char* T1 = L + 36864;
      __syncthreads();
      if (it < NIT) { ca = cvt_decode(a, it); CVT_LOAD(va, ca); }
      for (; it < NIT; it += 2 * G) {
          const int i2 = it + G, i3 = it + 2 * G;
          if (i2 < NIT) { cb = cvt_decode(a, i2); CVT_LOAD(vb, cb); }
          CVT_ITEM(va, ca, T0);
          if (i3 < NIT) { ca = cvt_decode(a, i3); CVT_LOAD(va, ca); }
          if (i2 < NIT) CVT_ITEM(vb, cb, T1);
      }
      __syncthreads(); }
    { const float* ck = a->in[I_CK]; const float* cvv = a->in[I_CV]; bf16* ckb = (bf16*)(a->ws + WS_CK); bf16* cvb = (bf16*)(a->ws + WS_CV);
      constexpr int NCH = 8 * PAST * KVW / 8;
      for (int i = gtid; i < 2 * NCH; i += NGT) {
          const bool isk = i < NCH; const int j = isk ? i : i - NCH; const float* s = (isk ? ck : cvv) + (size_t)j * 8;
          const f32x4 x0 = *(const f32x4*)s, x1 = *(const f32x4*)(s + 4);
          if (isk) { const int d = (j * 8) & 127; const size_t rowb = (size_t)(j * 8) & ~(size_t)127;
              const int p = (d & 64) | ((d & 16) << 1) | ((d & 8) << 1) | ((d & 32) >> 3);
              u32x2 w0, w1; w0.x = pk2(x0[0], x0[1]); w0.y = pk2(x0[2], x0[3]); w1.x = pk2(x1[0], x1[1]); w1.y = pk2(x1[2], x1[3]);
              *(u32x2*)(ckb + rowb + p) = w0; *(u32x2*)(ckb + rowb + p + 8) = w1; }
          else { u32x4 w; w.x = pk2(x0[0], x0[1]); w.y = pk2(x0[2], x0[3]); w.z = pk2(x1[0], x1[1]); w.w = pk2(x1[2], x1[3]); *(u32x4*)(cvb + (size_t)j * 8) = w; }
      } }
    { float* rc = (float*)(a->ws + WS_ROPE); float* rs = rc + 2048 * 64;
      for (int i = gtid; i < 2048 * 64; i += NGT) { const int pos = i >> 6, af = i & 63, axis = af >> 5, f = af & 31;
          const float inv = (float)pow(10000.0, -(double)f / 32.0); const float p = (float)(axis ? (pos & 63) : (pos >> 6)); const float ang = p * inv;
          rc[i] = (float)cos((double)ang); rs[i] = (float)sin((double)ang); } }
}
__device__ __forceinline__ const float* x_row(KA a, int row) { return row < NCTX ? a->in[I_XP] + (size_t)row * DM : a->in[I_XS] + (size_t)(row - NCTX) * DM; }
__device__ __forceinline__ int set_of(int row) { return row < NCTX ? 0 : 1 + ((row - NCTX) >> 11); }
template <int NV> __device__ __forceinline__ void fill_mod_lds(KA a, LAS float* L, int setLo, int setHi, const int (&vi)[NV], int tid) {
    const float* mod = (const float*)(a->ws + WS_MOD);
    for (int idx = tid; idx < 2 * NV * 1024; idx += NWAVES * 64) { const int bank = idx / (NV * 1024), v = (idx / 1024) % NV, c4 = idx & 1023;
        *(LAS f32x4*)(L + (size_t)((bank * NV + v) * 4096 + 4 * c4)) = *(const f32x4*)(mod + (size_t)(bank ? setHi : setLo) * 24576 + vi[v] * DM + 4 * c4); }
    __syncthreads();
}
#define LOADX(X, r) do { const float* _p = x_row(a, (r)) + 8 * lane; _Pragma("unroll") for (int j = 0; j < 8; ++j) { X[j][0] = __builtin_nontemporal_load((const f32x4*)(_p + 512 * j)); X[j][1] = __builtin_nontemporal_load((const f32x4*)(_p + 512 * j + 4)); } } while (0)
#define LOADY(Y, base, r) do { const bf16* _p = (base) + (size_t)(r) * DM + 8 * lane; _Pragma("unroll") for (int j = 0; j < 8; ++j) Y[j] = *(const u32x4*)(_p + 512 * j); } while (0)
#define LOADO(X, r) do { const float* _p = a->out + (size_t)(r) * DM + 8 * lane; _Pragma("unroll") for (int j = 0; j < 8; ++j) { X[j][0] = *(const f32x4*)(_p + 512 * j); X[j][1] = *(const f32x4*)(_p + 512 * j + 4); } } while (0)
__device__ __forceinline__ float ssq_x(const f32x4 (&x)[8][2]) { float ss = 0.f;
#pragma unroll
    for (int j = 0; j < 8; ++j)
#pragma unroll
        for (int h = 0; h < 2; ++h) ss += (x[j][h][0] * x[j][h][0] + x[j][h][1] * x[j][h][1]) + (x[j][h][2] * x[j][h][2] + x[j][h][3] * x[j][h][3]);
    return ss; }
__device__ __forceinline__ float ssq_y(const u32x4 (&yp)[8]) { float ss = 0.f;
#pragma unroll
    for (int j = 0; j < 8; ++j) { float y[8]; unpack8(yp[j], y);
#pragma unroll
        for (int e = 0; e < 8; ++e) ss += y[e] * y[e]; }
    return ss; }
__device__ __forceinline__ void p1_row(KA a, f32x4 (&x)[8][2], int row, const LAS float* L, int setLo, int lane) {
    const float rstd = rsqrtf(wave_sum(ssq_x(x)) * (1.f / DM) + EPS);
    const LAS float* Lb = L + (set_of(row) == setLo ? 0 : 2 * 4096) + 8 * lane; bf16* hrow = (bf16*)(a->ws + WS_H) + (size_t)row * DM + 8 * lane;
    float amax = 0.f;
#pragma unroll
    for (int j = 0; j < 8; ++j) {
#pragma unroll
        for (int h = 0; h < 2; ++h) { const int c = 512 * j + 4 * h; x[j][h] = (x[j][h] * rstd) * *(const LAS f32x4*)(Lb + c) + *(const LAS f32x4*)(Lb + 4096 + c);
            const f32x4 ab = __builtin_elementwise_abs(x[j][h]); amax = fmaxf(amax, fmaxf(fmaxf(ab[0], ab[1]), fmaxf(ab[2], ab[3]))); }
        *(u32x4*)(hrow + 512 * j) = pg8::pack8(x[j][0], x[j][1]); }
#pragma unroll
    for (int o = 1; o < 64; o <<= 1) amax = fmaxf(amax, __shfl_xor(amax, o));
    const float sa = amax > 0.f ? amax * (1.f / 127.f) : 1.f, inv = 1.f / sa;
    if (lane == 0) ((float*)(a->ws + WS_SA))[row] = sa;
    signed char* qrow = (signed char*)(a->ws + WS_H8) + (size_t)row * DM + 8 * lane;
#pragma unroll
    for (int j = 0; j < 8; ++j) { unsigned w[2];
#pragma unroll
        for (int h = 0; h < 2; ++h) { const f32x4 q = x[j][h] * inv;
            const int q0 = (int)rintf(q[0]), q1 = (int)rintf(q[1]), q2 = (int)rintf(q[2]), q3 = (int)rintf(q[3]);
            w[h] = (unsigned)(q0 & 255) | ((unsigned)(q1 & 255) << 8) | ((unsigned)(q2 & 255) << 16) | ((unsigned)(q3 & 255) << 24); }
        u32x2 pw; pw.x = w[0]; pw.y = w[1]; *(u32x2*)(qrow + 512 * j) = pw; }
}
template <int WHICH> __device__ __forceinline__ void p1_w8(KA a, int vcu, int G, int wave, int lane, int tid, LAS unsigned char* T) {
    constexpr int NBN = WHICH == 0 ? 56 : WHICH == 1 ? 86 : 16, N = WHICH == 0 ? INW : WHICH == 1 ? UPW : DM;
    const float* W = a->in[WHICH == 0 ? I_WIN : WHICH == 1 ? I_WUP : I_WAO]; const unsigned* cmax = (const unsigned*)(a->ws + WS_CTL) + (WHICH == 0 ? CW_CMAX : WHICH == 1 ? CW_CMAX2 : CW_CMAX3);
    signed char* W8 = (signed char*)(a->ws + (WHICH == 0 ? WS_W8 : WHICH == 1 ? WS_WUP8 : WS_WA8)); float* SB = (float*)(a->ws + (WHICH == 0 ? WS_SB : WHICH == 1 ? WS_SB2 : WS_SB3));
#define W8ROW(n_) (WHICH == 0 ? w8_row(n_) : WHICH == 1 ? wup8_row(n_) : (n_))
    for (int it = vcu; it < 32 * NBN; it += G) {
        const int kb = it / NBN, nq = it % NBN, nb = WHICH == 0 ? (nq < 24 ? nq : nq + 24) : nq;
        const int n = nb * 256 + 4 * lane;
        const float* src = W + (size_t)(kb * 128 + wave * 16) * N + n;
        f32x4 v[16];
#pragma unroll
        for (int j = 0; j < 16; ++j) v[j] = __builtin_nontemporal_load((const f32x4*)(src + (size_t)j * N));
        f32x4 inv;
#pragma unroll
        for (int i = 0; i < 4; ++i) { const float m = __uint_as_float(cmax[W8ROW(n + i)]); inv[i] = m > 0.f ? 127.f / m : 0.f; }
        __syncthreads();
#pragma unroll
        for (int i = 0; i < 4; ++i) { u32x4 w;
#pragma unroll
            for (int d = 0; d < 4; ++d) { unsigned x = 0;
#pragma unroll
                for (int e = 0; e < 4; ++e) { const int q = (int)rintf(v[4 * d + e][i] * inv[i]); x |= (unsigned)(q & 255) << (8 * e); }
                w[d] = x; }
            *(LAS u32x4*)(T + (4 * lane + i) * 144 + wave * 16) = w; }
        __syncthreads();
#pragma unroll
        for (int q = 0; q < 4; ++q) { const int idx = q * 512 + tid, row = idx >> 3, ch = idx & 7;
            const u32x4 w = *(const LAS u32x4*)(T + row * 144 + ch * 16);
            *(u32x4*)(W8 + (size_t)W8ROW(nb * 256 + row) * 4096 + kb * 128 + ch * 16) = w; }
        if (kb == 0 && tid < 256) { const float m = __uint_as_float(cmax[W8ROW(nb * 256 + tid)]); SB[W8ROW(nb * 256 + tid)] = m > 0.f ? m * (1.f / 127.f) : 1.f; }
    }
    __syncthreads();
#undef W8ROW
}
__device__ __forceinline__ void p1_h1(KA a, unsigned char* lds_g, int vcu, int G, int wave, int lane, int tid) {
    LAS float* L = (LAS float*)lds_g;
    const int nrb = (MTOT + G - 1) / G, base = vcu * nrb, lim = (base + nrb) < MTOT ? (base + nrb) : MTOT;
    if (base < MTOT) {
        const int setLo = set_of(base); { const int vi[2] = {1, 0}; fill_mod_lds<2>(a, L, setLo, set_of(lim - 1), vi, tid); }
        f32x4 xa[8][2], xb[8][2];
        int row = base + wave;
        if (row < lim) LOADX(xa, row);
        for (; row < lim; row += 2 * NWAVES) {
            const int r2 = row + NWAVES, r3 = row + 2 * NWAVES;
            if (r2 < lim) LOADX(xb, r2);
            p1_row(a, xa, row, L, setLo, lane);
            if (r3 < lim) LOADX(xa, r3);
            if (r2 < lim) p1_row(a, xb, r2, L, setLo, lane);
        }
    }
    p1_w8<0>(a, vcu, G, wave, lane, tid, (LAS unsigned char*)lds_g + 65536);
    p1_w8<1>(a, vcu, G, wave, lane, tid, (LAS unsigned char*)lds_g + 65536);
    p1_w8<2>(a, vcu, G, wave, lane, tid, (LAS unsigned char*)lds_g + 65536);
}
__device__ __forceinline__ void p6_row(KA a, const u32x4 (&yp)[8], f32x4 (&x)[8][2], int row, const LAS float* L, int setLo, int lane) {
    const float rstd = rsqrtf(wave_sum(ssq_y(yp)) * (1.f / DM) + EPS);
    const LAS float* Lb = L + (set_of(row) == setLo ? 0 : 3 * 4096) + 8 * lane; float* orow = a->out + (size_t)row * DM + 8 * lane; bf16* hrow = (bf16*)(a->ws + WS_H) + (size_t)row * DM + 8 * lane;
    float ss1 = 0.f;
#pragma unroll
    for (int j = 0; j < 8; ++j) { float y[8]; unpack8(yp[j], y);
#pragma unroll
        for (int h = 0; h < 2; ++h) { const int c = 512 * j + 4 * h; const f32x4 yv = (f32x4){y[4 * h], y[4 * h + 1], y[4 * h + 2], y[4 * h + 3]};
            const f32x4 x1 = x[j][h] + *(const LAS f32x4*)(Lb + c) * (yv * rstd);
            *(f32x4*)(orow + c) = x1; x[j][h] = x1; ss1 += (x1[0] * x1[0] + x1[1] * x1[1]) + (x1[2] * x1[2] + x1[3] * x1[3]); }
        asm volatile("" ::: "memory"); }
    const float rstd1 = rsqrtf(wave_sum(ss1) * (1.f / DM) + EPS);
    float amax = 0.f;
#pragma unroll
    for (int j = 0; j < 8; ++j) {
#pragma unroll
        for (int h = 0; h < 2; ++h) { const int c = 512 * j + 4 * h; x[j][h] = (x[j][h] * rstd1) * *(const LAS f32x4*)(Lb + 4096 + c) + *(const LAS f32x4*)(Lb + 2 * 4096 + c);
            const f32x4 ab = __builtin_elementwise_abs(x[j][h]); amax = fmaxf(amax, fmaxf(fmaxf(ab[0], ab[1]), fmaxf(ab[2], ab[3]))); }
        asm volatile("" ::: "memory"); }
#pragma unroll
    for (int o = 1; o < 64; o <<= 1) amax = fmaxf(amax, __shfl_xor(amax, o));
    const float sa = amax > 0.f ? amax * (1.f / 127.f) : 1.f, inv = 1.f / sa;
    if (lane == 0) ((float*)(a->ws + WS_SA))[row] = sa;
    signed char* qrow = (signed char*)(a->ws + WS_H8) + (size_t)row * DM + 8 * lane;
#pragma unroll
    for (int j = 0; j < 8; ++j) { unsigned w[2];
#pragma unroll
        for (int h = 0; h < 2; ++h) { const f32x4 q = x[j][h] * inv;
            const int q0 = (int)rintf(q[0]), q1 = (int)rintf(q[1]), q2 = (int)rintf(q[2]), q3 = (int)rintf(q[3]);
            w[h] = (unsigned)(q0 & 255) | ((unsigned)(q1 & 255) << 8) | ((unsigned)(q2 & 255) << 16) | ((unsigned)(q3 & 255) << 24); }
        u32x2 pw; pw.x = w[0]; pw.y = w[1]; *(u32x2*)(qrow + 512 * j) = pw; }
}
__device__ __forceinline__ void p6_x1_h2(KA a, unsigned char* lds_g, int vcu, int G, int wave, int lane, int tid) {
    LAS float* L = (LAS float*)lds_g; const bf16* Y = (const bf16*)(a->ws + WS_PROJ);
    const int nrb = (MTOT + G - 1) / G, base = vcu * nrb, lim = (base + nrb) < MTOT ? (base + nrb) : MTOT;
    if (base >= MTOT) return;
    const int setLo = set_of(base); { const int vi[3] = {2, 4, 3}; fill_mod_lds<3>(a, L, setLo, set_of(lim - 1), vi, tid); }
    u32x4 ya[8], yb[8]; f32x4 xa[8][2], xb[8][2];
    const int lane0 = lane;
    for (int row = base + wave; row < lim; row += 2 * NWAVES) {
        const int r2 = row + NWAVES;
        int lane = lane0; asm volatile("" : "+v"(lane));
        LOADY(ya, Y, row); LOADX(xa, row);
        if (r2 < lim) { LOADY(yb, Y, r2); LOADX(xb, r2); }
        p6_row(a, ya, xa, row, L, setLo, lane);
        if (r2 < lim) p6_row(a, yb, xb, r2, L, setLo, lane);
    }
}
#undef LOADX
#undef LOADY
#undef LOADO
constexpr int NR = 2;
__device__ __forceinline__ const float* mod_row(KA a, int row) { return (const float*)(a->ws + WS_MOD) + (size_t)set_of(row) * 24576; }
__device__ __forceinline__ void p10_final(KA a, int gw, int NGW, int lane, const bool dry) {
    const bf16* Fb = (const bf16*)(a->ws + WS_H);
    for (int row0 = gw; row0 < MTOT; row0 += NR * NGW) {
        int row[NR]; bool ok[NR]; u32x4 yp[NR][8]; f32x4 x[NR][8][2]; float rstd[NR];
#pragma unroll
        for (int i = 0; i < NR; ++i) { const int r = row0 + i * NGW; ok[i] = r < MTOT; row[i] = ok[i] ? r : row0;
            const bf16* frow = Fb + (size_t)row[i] * DM + 8 * lane; const float* orow = a->out + (size_t)row[i] * DM + 8 * lane;
#pragma unroll
            for (int j = 0; j < 8; ++j) yp[i][j] = *(const u32x4*)(frow + 512 * j);
#pragma unroll
            for (int j = 0; j < 8; ++j) { x[i][j][0] = *(const f32x4*)(orow + 512 * j); x[i][j][1] = *(const f32x4*)(orow + 512 * j + 4); } }
#pragma unroll
        for (int i = 0; i < NR; ++i) { float ss = 0.f;
#pragma unroll
            for (int j = 0; j < 8; ++j) { float y[8]; unpack8(yp[i][j], y);
#pragma unroll
                for (int e = 0; e < 8; ++e) ss += y[e] * y[e]; }
            rstd[i] = rsqrtf(wave_sum(ss) * (1.f / DM) + EPS); }
#pragma unroll
        for (int i = 0; i < NR; ++i) { const float* md = mod_row(a, row[i]) + 5 * DM + 8 * lane;
            float* orow = (dry ? (float*)(a->ws + WS_F) : a->out) + (size_t)row[i] * DM + 8 * lane;
#pragma unroll
            for (int j = 0; j < 8; ++j) { float y[8]; unpack8(yp[i][j], y);
#pragma unroll
                for (int h = 0; h < 2; ++h) { const int c = 512 * j + 4 * h; const f32x4 m5 = *(const f32x4*)(md + c);
                    const f32x4 yv = (f32x4){y[4 * h], y[4 * h + 1], y[4 * h + 2], y[4 * h + 3]};
                    if (ok[i]) *(f32x4*)(orow + c) = x[i][j][h] + m5 * (yv * rstd[i]); } }
        }
    }
}
__device__ __forceinline__ void p3_sconv(KA a, int gw, int NGW, int lane, const bool dry) {
    bf16* P = (bf16*)(a->ws + WS_PROJ); const float* w = a->in[I_WSCONV];
    for (int it = gw; it < (MTOT / 8) * 4; it += NGW) {
        const int r0 = (it >> 2) * 8, ch0 = (it & 3) * 512 + 8 * lane;
        const int L = r0 < NCTX ? 256 : 2048, t0 = r0 < NCTX ? (r0 & 255) : ((r0 - NCTX) & 2047);
        bf16* base = P + (size_t)r0 * INW + ch0;
        u32x4 cc[10], ch[10], cb[8];
        const u32x4 z = (u32x4){0u, 0u, 0u, 0u};
        if (t0 > 0) { cc[0] = *(const u32x4*)(base - INW + C_CC); ch[0] = *(const u32x4*)(base - INW + C_CH); } else { cc[0] = z; ch[0] = z; }
#pragma unroll
        for (int i = 0; i < 8; ++i) { cc[i + 1] = *(const u32x4*)(base + (size_t)i * INW + C_CC); ch[i + 1] = *(const u32x4*)(base + (size_t)i * INW + C_CH); cb[i] = *(const u32x4*)(base + (size_t)i * INW + C_CB); }
        if (t0 + 8 < L) { cc[9] = *(const u32x4*)(base + (size_t)8 * INW + C_CC); ch[9] = *(const u32x4*)(base + (size_t)8 * INW + C_CH); } else { cc[9] = z; ch[9] = z; }
        float w0[8], w1[8], w2[8];
#pragma unroll
        for (int e = 0; e < 8; ++e) { w0[e] = w[ch0 + e]; w1[e] = w[CONVD + ch0 + e]; w2[e] = w[2 * CONVD + ch0 + e]; }
        float prev[8], cur[8], nxt[8], t1[8], t2[8];
        unpack8(cc[0], t1); unpack8(ch[0], t2);
#pragma unroll
        for (int e = 0; e < 8; ++e) prev[e] = t1[e] * t2[e];
        unpack8(cc[1], t1); unpack8(ch[1], t2);
#pragma unroll
        for (int e = 0; e < 8; ++e) cur[e] = t1[e] * t2[e];
#pragma unroll
        for (int i = 0; i < 8; ++i) {
            unpack8(cc[i + 2], t1); unpack8(ch[i + 2], t2);
#pragma unroll
            for (int e = 0; e < 8; ++e) nxt[e] = t1[e] * t2[e];
            float cbf[8], o[8]; unpack8(cb[i], cbf);
#pragma unroll
            for (int e = 0; e < 8; ++e) { o[e] = cbf[e] * (w0[e] * prev[e] + w1[e] * cur[e] + w2[e] * nxt[e]); prev[e] = cur[e]; cur[e] = nxt[e]; }
            if (dry) *(u32x4*)((bf16*)(a->ws + WS_H) + (size_t)(r0 + i) * DM + ch0) = pack8f(o); else *(u32x4*)(base + (size_t)i * INW + C_CB) = pack8f(o);
        }
    }
}
__device__ __forceinline__ void p4_quant_a(KA a, int gw, int NGW, int lane) {
    const bf16* P = (const bf16*)(a->ws + WS_PROJ); signed char* A8 = (signed char*)(a->ws + WS_H8); float* SA = (float*)(a->ws + WS_SA);
    for (int row0 = gw; row0 < MTOT; row0 += 2 * NGW) {
        u32x4 v[2][8]; int row[2]; bool ok[2];
#pragma unroll
        for (int i = 0; i < 2; ++i) { const int r = row0 + i * NGW; ok[i] = r < MTOT; row[i] = ok[i] ? r : row0; const bf16* p = P + (size_t)row[i] * INW + C_Q + 8 * lane;
#pragma unroll
            for (int j = 0; j < 8; ++j) v[i][j] = *(const u32x4*)(p + 512 * j); }
#pragma unroll
        for (int i = 0; i < 2; ++i) { float amax = 0.f;
#pragma unroll
            for (int j = 0; j < 8; ++j) { float f[8]; unpack8(v[i][j], f);
#pragma unroll
                for (int e = 0; e < 8; ++e) amax = fmaxf(amax, fabsf(f[e])); }
#pragma unroll
            for (int o = 1; o < 64; o <<= 1) amax = fmaxf(amax, __shfl_xor(amax, o));
            const float sa = amax > 0.f ? amax * (1.f / 127.f) : 1.f, inv = 1.f / sa;
            if (ok[i]) { if (lane == 0) SA[row[i]] = sa;
#pragma unroll
                for (int j = 0; j < 8; ++j) { float f[8]; unpack8(v[i][j], f); unsigned w[2];
#pragma unroll
                    for (int h = 0; h < 2; ++h) { const int q0 = (int)rintf(f[4 * h] * inv), q1 = (int)rintf(f[4 * h + 1] * inv), q2 = (int)rintf(f[4 * h + 2] * inv), q3 = (int)rintf(f[4 * h + 3] * inv);
                        w[h] = (unsigned)(q0 & 255) | ((unsigned)(q1 & 255) << 8) | ((unsigned)(q2 & 255) << 16) | ((unsigned)(q3 & 255) << 24); }
                    u32x2 pw; pw.x = w[0]; pw.y = w[1]; *(u32x2*)(A8 + (size_t)row[i] * DM + 512 * j + 8 * lane) = pw; } }
        }
    }
}
__device__ __forceinline__ void p8_fixup(KA a, int gtid, int NGT) {
    bf16* Fb = (bf16*)(a->ws + WS_F); const float* w = a->in[I_WFCONV]; const float* sbg = (const float*)(a->ws + WS_SBG); const float* sbv = (const float*)(a->ws + WS_SBV);
    constexpr int NC4 = DFF / 4;
    for (int i = gtid; i < 56 * NC4; i += NGT) {
        const int sidx = i / NC4, c = (i % NC4) * 4; const int T = 32 + (sidx / 7) * 8 + (sidx % 7);
        const f32x4 gA254 = *(const f32x4*)(sbg + ((size_t)T * 4 + 2) * DFF + c), gA255 = *(const f32x4*)(sbg + ((size_t)T * 4 + 3) * DFF + c);
        const f32x4 gB0 = *(const f32x4*)(sbg + ((size_t)(T + 1) * 4 + 0) * DFF + c), gB1 = *(const f32x4*)(sbg + ((size_t)(T + 1) * 4 + 1) * DFF + c);
        const f32x4 vA = *(const f32x4*)(sbv + ((size_t)T * 2 + 1) * DFF + c), vB = *(const f32x4*)(sbv + ((size_t)(T + 1) * 2) * DFF + c);
        const f32x4 w0 = *(const f32x4*)(w + c), w1 = *(const f32x4*)(w + DFF + c), w2 = *(const f32x4*)(w + 2 * DFF + c);
        const f32x4 ca = w0 * gA254 + w1 * gA255 + w2 * gB0, cb = w0 * gA255 + w1 * gB0 + w2 * gB1;
        f32x4 oa, ob;
#pragma unroll
        for (int j = 0; j < 4; ++j) { oa[j] = ca[j] * __builtin_amdgcn_rcpf(1.f + __expf(-ca[j])) * vA[j]; ob[j] = cb[j] * __builtin_amdgcn_rcpf(1.f + __expf(-cb[j])) * vB[j]; }
        u32x2 pa, pb; pa.x = pk2(oa[0], oa[1]); pa.y = pk2(oa[2], oa[3]); pb.x = pk2(ob[0], ob[1]); pb.y = pk2(ob[2], ob[3]);
        *(u32x2*)(Fb + ((size_t)T * 256 + 255) * DFF + c) = pa; *(u32x2*)(Fb + ((size_t)(T + 1) * 256) * DFF + c) = pb;
    }
}
__device__ __forceinline__ void p3_attention(KA a, char* lds, int vcu, int G, int tid, const bool dry) {
    bf16* P = (bf16*)(a->ws + WS_PROJ); const bf16* CKb = (const bf16*)(a->ws + WS_CK); const bf16* CVb = (const bf16*)(a->ws + WS_CV); const float* sinkp = a->in[I_SINK];
    const int wid = tid >> 6, lane = tid & 63, r32 = lane & 31, hi = lane >> 5;
    const int perL = (2048 + G - 1) / G, perC = (1024 + G - 1) / G;
    for (int i = 0; i < perL + perC; ++i) {
        const bool lat = i < perL;
        const int id = lat ? vcu * perL + i : vcu * perC + (i - perL);
        if (id >= (lat ? 2048 : 1024)) continue;
        att::Src S; int rowbase, kvh, hp, qb;
        if (lat) { hp = id & 1; qb = (id >> 1) & 15; kvh = (id >> 5) & 7; const int b = id >> 8; rowbase = NCTX + b * 2048;
            const int kb_lo = qb > 0 ? qb - 1 : 0, kb_hi = qb < 15 ? qb + 1 : 15;
            S.nA = 8; S.KA = CKb + (size_t)b * PAST * KVW + kvh * 128; S.VA = CVb + (size_t)b * PAST * KVW + kvh * 128;
            S.nB = (kb_hi - kb_lo + 1) * 2; S.kpos0 = kb_lo * 128; S.masked = 1; }
        else { hp = id & 1; qb = (id >> 1) & 1; kvh = (id >> 2) & 7; const int b = id >> 5; rowbase = b * 256;
            S.nA = 0; S.KA = CKb; S.VA = CVb; S.nB = 4; S.kpos0 = 0; S.masked = 0; }
        S.qpos0 = qb * 128;
        S.KB = P + (size_t)(rowbase + S.kpos0) * INW + C_K + kvh * 128; S.VB = P + (size_t)(rowbase + S.kpos0) * INW + C_V + kvh * 128;
        const int head = kvh * 4 + hp * 2 + (wid >> 2);
        const size_t qrow0 = (size_t)rowbase + qb * 128 + 32 * (wid & 3);
        bf16* Ow = dry ? (bf16*)(a->ws + WS_H) + qrow0 * DM + head * 128 : P + qrow0 * INW + C_Q + head * 128;
        att::attn_unit(P + (qrow0 + r32) * INW + C_Q + head * 128 + hi * 8, Ow, S, sinkp[head], lds, tid, dry ? DM : INW);
    }
}

__global__ void __launch_bounds__(NWAVES * 64, 2) mk_fwd(Args args_) {
    const KA kp = (KA)__builtin_amdgcn_kernarg_segment_ptr(); (void)args_;
#define args (launder(kp))
    extern __shared__ __attribute__((aligned(16))) unsigned char lds[];
    const int wave = __builtin_amdgcn_readfirstlane((int)threadIdx.x >> 6);
#define LANE_TID() const int lane = lane_id(); const int tid = wave * 64 + lane; (void)tid; (void)lane
    const int G = gridDim.x; const int bx = blockIdx.x; const int vcu = (G % 8 == 0) ? (bx % 8) * (G / 8) + bx / 8 : bx;
    const int gw = vcu * NWAVES + wave, NGW = G * NWAVES;
    LAS unsigned char* ldsl = (LAS unsigned char*)lds;
    volatile LAS unsigned* MISC = (volatile LAS unsigned*)(ldsl + MISC_OFF);
    { LANE_TID(); for (int u = tid; u < (LDS_BYTES - RING_BYTES) / 4; u += NWAVES * 64) ((LAS unsigned*)(ldsl + RING_BYTES))[u] = 0u; }
    __syncthreads();
    unsigned* ctl = (unsigned*)(args->ws + WS_CTL);
    XcdBarrier bar; bar.bar = ctl + CW_BAR; bar.x = 0; bar.st = nullptr;
    if (N_LAUNCHES == 1) { LANE_TID(); bar = xcd_barrier_post(ctl + CW_BAR, MISC + 8, tid); }
    const int lo = args->ph_lo, hi = args->ph_hi;
#ifndef PHASE_MASK
#define PHASE_MASK 0x7ff
#endif
#define IN(k) ((((PHASE_MASK) >> (k)) & 1) && lo <= (k) && (k) < hi)
#ifndef REPEAT_MASK
#define REPEAT_MASK 0
#endif
#ifndef PROBE_P0
#define PROBE_P0 0
#endif
#ifndef PROBE_DRY
#define PROBE_DRY 0
#endif
#define REPS(k) (1 + ((((REPEAT_MASK) | (PROBE_DRY)) >> (k)) & 1))
#define SEAM(k) do { if (IN(k) && IN((k) + 1)) { LANE_TID(); xcd_barrier(bar, tid); } } while (0)
#define Hb ((bf16*)(args->ws + WS_H))
#define Pb ((bf16*)(args->ws + WS_PROJ))
#define Fb ((bf16*)(args->ws + WS_F))

    if (IN(0)) for (int rep_ = 0; rep_ < REPS(0); ++rep_) { LANE_TID();
        for (int r2 = 0; r2 < 1 + (PROBE_P0 & 1); ++r2) p0_mod(args, lds, tid, G);
        for (int r2 = 0; r2 < 1 + (PROBE_P0 >> 1 & 1); ++r2) p0_convert(args, vcu, G, wave, lane, tid, gw * 64 + lane, NGW * 64, ldsl); }
    SEAM(0);
    if (IN(1)) for (int rep_ = 0; rep_ < REPS(1); ++rep_) { LANE_TID(); p1_h1(args, lds, vcu, G, wave, lane, tid); }
    SEAM(1);
    if (IN(2)) for (int rep_ = 0; rep_ < REPS(2); ++rep_) {
        LANE_TID();
        { pg8::Gemm g{Hb, (const bf16*)(args->ws + WS_WIN), MTOT, 8192, DM, DM, 1 << 30, 0}; pg8::InOrder S; S.G = G; S.c = vcu; S.i8 = false;
          pg8::EpiIn E{Pb, args->out + O_NK, args->out + O_NV, (const float*)(args->ws + WS_ROPE), (const float*)(args->ws + WS_ROPE) + 2048 * 64};
          pg8::gemm_phase<pg8::EpiIn, pg8::InOrder, true>(ldsl, g, S, E, tid); }
        { pg8::Gemm g{(const bf16*)(args->ws + WS_H8), (const bf16*)(args->ws + WS_W8), MTOT, 14336, DM, DM, 1 << 30, 0}; pg8::InOrder S; S.G = G; S.c = vcu; S.i8 = true;
          pg8::EpiIn8 E{Pb, (const float*)(args->ws + WS_SA), (const float*)(args->ws + WS_SB), (const float*)(args->ws + WS_ROPE), (const float*)(args->ws + WS_ROPE) + 2048 * 64};
          pg8::gemm_phase<pg8::EpiIn8, pg8::InOrder, true, true>(ldsl, g, S, E, tid); }
    }
    SEAM(2);
    if (IN(3)) for (int rep_ = 0; rep_ < REPS(3); ++rep_) { LANE_TID(); const bool dry = (PROBE_DRY >> 3 & 1) && rep_ == 0; p3_attention(args, (char*)lds, vcu, G, tid, dry); p3_sconv(args, gw, NGW, lane, dry); }
    SEAM(3);
    if (IN(4)) for (int rep_ = 0; rep_ < REPS(4); ++rep_) {
        LANE_TID();
        p4_quant_a(args, gw, NGW, lane);
        if (lo < hi - 1 || N_LAUNCHES == 1) xcd_barrier(bar, tid);
        { pg8::Gemm g{(const bf16*)(args->ws + WS_H8), (const bf16*)(args->ws + WS_WA8), MTOT, DM, DM, DM, 1 << 30, 0}; pg8::GroupOrder S; S.init(MTOT, DM, G, vcu);
          pg8::EpiT1 E{Pb, Hb, (const float*)(args->ws + WS_SA), (const float*)(args->ws + WS_SB3)};
          pg8::gemm_phase<pg8::EpiT1, pg8::GroupOrder, true, true>(ldsl, g, S, E, tid); }
        { pg8::Gemm g{Pb + C_CB, (const bf16*)(args->ws + WS_WCAT), MTOT, DM, CONVD, INW, 1 << 30, 0}; pg8::GroupOrder S; S.init(MTOT, DM, G, vcu);
          pg8::EpiMerge2 E{Pb, Hb};
          pg8::gemm_phase<pg8::EpiMerge2, pg8::GroupOrder, true>(ldsl, g, S, E, tid); }
    }
    SEAM(4);
    if (IN(5)) for (int rep_ = 0; rep_ < REPS(5); ++rep_) {
        pg8::Gemm g{Hb, (const bf16*)(args->ws + WS_WMIX), MTOT, DM, DM, DM, 1 << 30, 0}; LANE_TID(); pg8::GroupOrder S; S.init(MTOT, DM, G, vcu);
        pg8::EpiStore E{Pb, DM};
        pg8::gemm_phase<pg8::EpiStore, pg8::GroupOrder, true>(ldsl, g, S, E, tid);
    }
    SEAM(5);
    if (IN(6)) for (int rep_ = 0; rep_ < REPS(6); ++rep_) { LANE_TID(); p6_x1_h2(args, lds, vcu, G, wave, lane, tid); }
    SEAM(6);
    if (IN(7)) for (int rep_ = 0; rep_ < REPS(7); ++rep_) {
        LANE_TID();
        pg8::Gemm g{(const bf16*)(args->ws + WS_H8), (const bf16*)(args->ws + WS_WUP8), MTOT, UPW, DM, DM, 1 << 30, 0}; pg8::GroupOrder S; S.init(MTOT, UPW, G, vcu);
        pg8::EpiUp E{Fb, args->in[I_WFCONV], (float*)(args->ws + WS_SBG), (float*)(args->ws + WS_SBV), (LAS float*)(ldsl + RING_BYTES + 1024), (const float*)(args->ws + WS_SA), (const float*)(args->ws + WS_SB2)};
        pg8::gemm_phase<pg8::EpiUp, pg8::GroupOrder, true, true>(ldsl, g, S, E, tid);
    }
    SEAM(7);
    if (IN(8)) for (int rep_ = 0; rep_ < REPS(8); ++rep_) { LANE_TID(); p8_fixup(args, gw * 64 + lane, NGW * 64); }
    SEAM(8);
    if (IN(9)) for (int rep_ = 0; rep_ < REPS(9); ++rep_) {
        pg8::Gemm g{Fb, (const bf16*)(args->ws + WS_WDN), MTOT, DM, DFF, DFF, 1 << 30, 0}; LANE_TID(); pg8::GroupOrder S; S.init(MTOT, DM, G, vcu);
        pg8::EpiStore E{Hb, DM};
        pg8::gemm_phase<pg8::EpiStore, pg8::GroupOrder, true>(ldsl, g, S, E, tid);
    }
    SEAM(9);
    if (IN(10)) for (int rep_ = 0; rep_ < REPS(10); ++rep_) { LANE_TID(); const bool dry = (PROBE_DRY >> 10 & 1) && rep_ == 0; p10_final(args, gw, NGW, lane, dry); }
#undef IN
#undef SEAM
#undef Hb
#undef Pb
#undef Fb
#undef args
}

extern "C" void kernel_launch(void* const* d_in, const int* in_sizes, int n_in, void* d_out, int out_size, void* d_ws, size_t ws_size, hipStream_t stream) {
    static int grid = 0;
    if (grid == 0) {
        if (n_in != 21 || (size_t)out_size != O_END || ws_size < WS_END) { fprintf(stderr, "kernel_launch: shape mismatch (n_in %d out %d ws %zu; need ws >= %zu)\n", n_in, out_size, ws_size, (size_t)WS_END); grid = -1; return; }
        int dev = 0, cus = 0;
        if (hipGetDevice(&dev) != hipSuccess || hipDeviceGetAttribute(&cus, hipDeviceAttributeMultiprocessorCount, dev) != hipSuccess) { grid = -1; return; }
        if (hipFuncSetAttribute((const void*)mk_fwd, hipFuncAttributeMaxDynamicSharedMemorySize, LDS_BYTES) != hipSuccess) { fprintf(stderr, "kernel_launch: hipFuncSetAttribute failed\n"); grid = -1; return; }
        int per_cu = 0;
        if (hipOccupancyMaxActiveBlocksPerMultiprocessor(&per_cu, (const void*)mk_fwd, NWAVES * 64, LDS_BYTES) != hipSuccess || per_cu < 1) fprintf(stderr, "kernel_launch: occupancy query reports %d\n", per_cu);
        (void)hipGetLastError();
        grid = cus;
    }
    if (grid < 0) return;
    (void)hipMemsetAsync((char*)d_ws + WS_CTL, 0, CTL_ZERO_BYTES, stream);
    Args a{};
    for (int i = 0; i < 21; ++i) a.in[i] = (const float*)d_in[i];
    a.out = (float*)d_out; a.ws = (unsigned char*)d_ws;
    for (int li = 0; li < N_LAUNCHES; ++li) {
        a.ph_lo = (N_LAUNCHES == 1) ? 0 : li; a.ph_hi = (N_LAUNCHES == 1) ? N_PHASES : li + 1;
        hipLaunchKernelGGL(mk_fwd, dim3(grid), dim3(NWAVES * 64), LDS_BYTES, stream, a);
    }
}
```
